# Optimizing an MI355X kernel written in HIP

```python
import math, functools
import jax, jax.numpy as jnp
from jax import lax
import numpy as np

D_MODEL = 2048
BATCH = 4
SEQ = 4096
DEPTH = 2
DEC_BATCH = 16
DEC_SEQ = 16
PAST_LEN = 2048

CHUNK = 64
N_BRANCH = 3
BRANCH_WIDTH = 1024
POOL_WIDTH = BRANCH_WIDTH
POOL_WINDOWS = (2, 4, 8, 16)
POOL_GROUPS = len(POOL_WINDOWS)
POOL_GROUP_DIM = POOL_WIDTH // POOL_GROUPS
POOL_HIST = max(POOL_WINDOWS) - 1
RWKV_WIDTH = BRANCH_WIDTH
RWKV_HEAD = 64
RWKV_HEADS = RWKV_WIDTH // RWKV_HEAD
DECAY_RANK = 64
ICLR_RANK = 64
SHIFT_WIDTH = 3 * RWKV_WIDTH + DECAY_RANK + ICLR_RANK
GN_EPS = 64e-5
ATT_HEADS = 16
ATT_KV_HEADS = 4
ATT_GROUP = ATT_HEADS // ATT_KV_HEADS
ATT_HEAD_DIM = 64
ATT_WIDTH = ATT_HEADS * ATT_HEAD_DIM
KV_WIDTH = ATT_KV_HEADS * ATT_HEAD_DIM
WINDOW = 128
BAND_CHUNKS = WINDOW // CHUNK
BAND_KEYS = (BAND_CHUNKS + 1) * CHUNK
ATT_SCALE = ATT_HEAD_DIM ** -0.5
N_BUCKETS = 32
MAX_DISTANCE = 128
NEG_INF = -1e30
RMS_EPS = 1e-6
OFF_POOL = 0
OFF_SHIFT = OFF_POOL + POOL_WIDTH
OFF_Q = OFF_SHIFT + SHIFT_WIDTH
OFF_K = OFF_Q + ATT_WIDTH
OFF_V = OFF_K + KV_WIDTH
OFF_GATE = OFF_V + KV_WIDTH
OFF_MERGE = OFF_GATE + N_BRANCH * BRANCH_WIDTH
IN_WIDTH = OFF_MERGE + N_BRANCH * D_MODEL

kernel_name = 'hybrid_pool_rwkv7_swa_stream_step'


def rms_norm(x, g):
    xf = x.astype(jnp.float32)
    y = xf * lax.rsqrt(jnp.mean(xf * xf, axis=-1, keepdims=True) + RMS_EPS)
    return (y * g.astype(jnp.float32)).astype(x.dtype)


def t5_bucket(rel):
    half = N_BUCKETS // 2
    n = -rel
    ret = jnp.where(n < 0, half, 0)
    n = jnp.abs(n)
    max_exact = half // 2
    large = max_exact + (jnp.log(jnp.maximum(n, 1).astype(jnp.float32) / max_exact)
                         / math.log(MAX_DISTANCE / max_exact) * (half - max_exact)).astype(jnp.int32)
    large = jnp.minimum(large, half - 1)
    return ret + jnp.where(n < max_exact, n, large)


def rel_bias(table, rel):
    return jnp.transpose(table[t5_bucket(rel)], (2, 0, 1)).astype(jnp.float32)


def sink_softmax(logits, sink):
    sink = jnp.broadcast_to(sink.astype(jnp.float32), logits.shape[:-1] + (1,))
    return jax.nn.softmax(jnp.concatenate([logits, sink], axis=-1), axis=-1)[..., :-1]


def pool_mix(u, hist, pos0):
    T = u.shape[1]
    ext = jnp.concatenate([hist.astype(u.dtype), u], axis=1).astype(jnp.float32)
    cs = jnp.concatenate([jnp.zeros_like(ext[:, :1]), jnp.cumsum(ext, axis=1)], axis=1)
    end = cs[:, POOL_HIST + 1:]
    pos = pos0 + jnp.arange(T)
    outs = []
    for g, w in enumerate(POOL_WINDOWS):
        sl = slice(g * POOL_GROUP_DIM, (g + 1) * POOL_GROUP_DIM)
        s = end[..., sl] - cs[:, POOL_HIST + 1 - w:POOL_HIST + 1 - w + T, sl]
        cnt = jnp.minimum(w, pos + 1).astype(jnp.float32)[None, :, None]
        outs.append(s / cnt)
    return (jnp.concatenate(outs, axis=-1) - u.astype(jnp.float32)).astype(u.dtype)


def rwkv_scan(r, w, k, v, a, b, s0):
    def step(s, inp):
        r_t, w_t, k_t, v_t, a_t, b_t = inp
        sa = jnp.einsum('bhij,bhj->bhi', s, a_t)
        s = s * w_t[:, :, None, :] + sa[..., None] * b_t[:, :, None, :] + v_t[..., None] * k_t[:, :, None, :]
        return s, jnp.einsum('bhij,bhj->bhi', s, r_t)
    xs = tuple(jnp.moveaxis(z, 1, 0) for z in (r, w, k, v, a, b))
    s, ys = lax.scan(step, s0, xs)
    return jnp.moveaxis(ys, 0, 1), s


def rwkv_branch(p, prev_row, s0, mu, w0, w_up, a0, a_up, k_k, k_a, r_k, gn_w, gn_b):
    B, T, _ = p.shape
    W = RWKV_WIDTH
    prev = jnp.concatenate([prev_row[:, None, :].astype(p.dtype), p[:, :-1]], axis=1)
    xs = p + (prev - p) * mu
    r, k, v = xs[..., :W], xs[..., W:2 * W], xs[..., 2 * W:3 * W]
    wd, ad = xs[..., 3 * W:3 * W + DECAY_RANK], xs[..., 3 * W + DECAY_RANK:]
    w_log = -jax.nn.softplus(-(w0 + jnp.tanh(wd) @ w_up)) - 0.5
    decay = jnp.exp(-jnp.exp(w_log.astype(jnp.float32)))
    a = jax.nn.sigmoid(a0 + ad @ a_up)
    heads = lambda z: z.astype(jnp.float32).reshape(B, T, RWKV_HEADS, RWKV_HEAD)
    kk = heads(k * k_k)
    kk = kk / jnp.maximum(jnp.sqrt(jnp.sum(kk * kk, axis=-1, keepdims=True)), 1e-12)
    k = k * (1 + (a - 1) * k_a)
    rh, kh, vh, ah, wh = heads(r), heads(k), heads(v), heads(a), heads(decay)
    y, s = rwkv_scan(rh, wh, kh, vh, -kk, kk * ah, s0.astype(jnp.float32))
    mean = jnp.mean(y, axis=-1, keepdims=True)
    var = jnp.mean(jnp.square(y - mean), axis=-1, keepdims=True)
    y = ((y - mean) * lax.rsqrt(var + GN_EPS)).reshape(B, T, W) * gn_w.astype(jnp.float32) + gn_b.astype(jnp.float32)
    bonus = jnp.sum(rh * kh * r_k.astype(jnp.float32).reshape(RWKV_HEADS, RWKV_HEAD), axis=-1, keepdims=True) * vh
    y = y + bonus.reshape(B, T, W)
    return y.astype(p.dtype), s


def swa_prompt(q, k, v, sink, bias):
    B, T = q.shape[:2]
    nc = T // CHUNK
    qb = q.reshape(B, nc, CHUNK, ATT_KV_HEADS, ATT_GROUP, ATT_HEAD_DIM)

    def band(z):
        zb = z.reshape(B, nc, CHUNK, ATT_KV_HEADS, ATT_HEAD_DIM)
        zp = jnp.pad(zb, ((0, 0), (BAND_CHUNKS, 0), (0, 0), (0, 0), (0, 0)))
        return jnp.concatenate([zp[:, i:i + nc] for i in range(BAND_CHUNKS + 1)], axis=2)

    kb, vb = band(k), band(v)
    logits = jnp.einsum('bnqkgd,bnskd->bnkgqs', qb, kb).astype(jnp.float32) * ATT_SCALE
    logits = logits + bias.reshape(ATT_KV_HEADS, ATT_GROUP, CHUNK, BAND_KEYS)
    key_chunk = jnp.arange(nc)[:, None] - BAND_CHUNKS + jnp.arange(BAND_KEYS)[None, :] // CHUNK
    logits = jnp.where((key_chunk >= 0)[None, :, None, None, None, :], logits, NEG_INF)
    probs = sink_softmax(logits, sink.reshape(ATT_KV_HEADS, ATT_GROUP)[:, :, None, None])
    out = jnp.einsum('bnkgqs,bnskd->bnqkgd', probs.astype(vb.dtype), vb)
    return out.reshape(B, T, ATT_WIDTH)


def swa_sample(q, k, v, k_cache, v_cache, sink, bias):
    B, T = q.shape[:2]
    kk = jnp.concatenate([k_cache.astype(k.dtype), k], axis=1)
    vv = jnp.concatenate([v_cache.astype(v.dtype), v], axis=1)
    S = kk.shape[1]
    qh = q.reshape(B, T, ATT_KV_HEADS, ATT_GROUP, ATT_HEAD_DIM)
    logits = jnp.einsum('btkgd,bskd->bkgts', qh, kk).astype(jnp.float32) * ATT_SCALE
    logits = logits + bias.reshape(ATT_KV_HEADS, ATT_GROUP, T, S)
    probs = sink_softmax(logits, sink.reshape(ATT_KV_HEADS, ATT_GROUP)[:, :, None, None])
    out = jnp.einsum('bkgts,bskd->btkgd', probs.astype(vv.dtype), vv)
    return out.reshape(B, T, ATT_WIDTH)


def mixer_layer(x, pos0, pool_hist, shift_prev, s0, attn_fn, norm_g, w_in, pool_w, pool_scale, mu, w0, w_up,
                a0, a_up, k_k, k_a, r_k, gn_w, gn_b, w_branch, w_out):
    B, T, _ = x.shape
    h = rms_norm(x, norm_g)
    proj = h @ w_in
    u_pool = proj[..., OFF_POOL:OFF_SHIFT]
    p_shift = proj[..., OFF_SHIFT:OFF_Q]
    q = proj[..., OFF_Q:OFF_K].reshape(B, T, ATT_HEADS, ATT_HEAD_DIM)
    k = proj[..., OFF_K:OFF_V].reshape(B, T, ATT_KV_HEADS, ATT_HEAD_DIM)
    v = proj[..., OFF_V:OFF_GATE].reshape(B, T, ATT_KV_HEADS, ATT_HEAD_DIM)
    zg = jax.nn.silu(proj[..., OFF_GATE:OFF_MERGE]).reshape(B, T, N_BRANCH, BRANCH_WIDTH)
    mg = jax.nn.sigmoid(proj[..., OFF_MERGE:]).reshape(B, T, N_BRANCH, D_MODEL)
    pooled = pool_mix(u_pool, pool_hist, pos0).reshape(B, T, POOL_GROUPS, POOL_GROUP_DIM)
    o_a = jnp.einsum('btgc,gcd->btgd', pooled, pool_w).reshape(B, T, POOL_WIDTH) * pool_scale
    o_b, s_new = rwkv_branch(p_shift, shift_prev, s0, mu, w0, w_up, a0, a_up, k_k, k_a, r_k, gn_w, gn_b)
    o_c = attn_fn(q, k, v).astype(x.dtype)
    merged = (mg[:, :, 0] * ((o_a * zg[:, :, 0]) @ w_branch[0])
              + mg[:, :, 1] * ((o_b * zg[:, :, 1]) @ w_branch[1])
              + mg[:, :, 2] * ((o_c * zg[:, :, 2]) @ w_branch[2]))
    y = x + merged @ w_out
    new_pool = jnp.concatenate([pool_hist.astype(u_pool.dtype), u_pool], axis=1)[:, -POOL_HIST:]
    return y, k, v, s_new, p_shift[:, -1], new_pool


def setup_inputs(seed: int = 0) -> dict:
    key = jax.random.key(seed)
    ks = jax.random.split(key, 26)
    f32 = jnp.float32
    nrm = lambda kk, shape, s: s * jax.random.normal(kk, shape, f32)
    n_cache = min(WINDOW, PAST_LEN)
    return {
        'x_prompt': nrm(ks[0], (BATCH, SEQ, D_MODEL), 1.0),
        'x_sample': nrm(ks[1], (DEC_BATCH, DEC_SEQ, D_MODEL), 1.0),
        'cache_attn_k': nrm(ks[2], (DEPTH, DEC_BATCH, n_cache, ATT_KV_HEADS, ATT_HEAD_DIM), 1.0),
        'cache_attn_v': nrm(ks[3], (DEPTH, DEC_BATCH, n_cache, ATT_KV_HEADS, ATT_HEAD_DIM), 1.0),
        'state_rwkv': nrm(ks[4], (DEPTH, DEC_BATCH, RWKV_HEADS, RWKV_HEAD, RWKV_HEAD), 0.3),
        'state_rwkv_shift': nrm(ks[5], (DEPTH, DEC_BATCH, SHIFT_WIDTH), 1.0),
        'state_pool': nrm(ks[6], (DEPTH, DEC_BATCH, POOL_HIST, POOL_WIDTH), 1.0),
        'norm_g': 1.0 + nrm(ks[7], (DEPTH, D_MODEL), 0.05),
        'w_in': nrm(ks[8], (DEPTH, D_MODEL, IN_WIDTH), D_MODEL ** -0.5),
        'pool_w': nrm(ks[9], (DEPTH, POOL_GROUPS, POOL_GROUP_DIM, POOL_GROUP_DIM), POOL_GROUP_DIM ** -0.5),
        'pool_scale': 1.0 + nrm(ks[10], (DEPTH, POOL_WIDTH), 0.1),
        'rwkv_mu': jax.random.uniform(ks[11], (DEPTH, SHIFT_WIDTH), f32),
        'rwkv_w0': jax.random.uniform(ks[12], (DEPTH, RWKV_WIDTH), f32, -6.0, 1.0),
        'rwkv_w_up': nrm(ks[13], (DEPTH, DECAY_RANK, RWKV_WIDTH), 0.5 * DECAY_RANK ** -0.5),
        'rwkv_a0': nrm(ks[14], (DEPTH, RWKV_WIDTH), 0.1),
        'rwkv_a_up': nrm(ks[15], (DEPTH, ICLR_RANK, RWKV_WIDTH), 0.5 * ICLR_RANK ** -0.5),
        'rwkv_k_k': 0.85 + nrm(ks[16], (DEPTH, RWKV_WIDTH), 0.05),
        'rwkv_k_a': 1.0 + nrm(ks[17], (DEPTH, RWKV_WIDTH), 0.05),
        'rwkv_r_k': nrm(ks[18], (DEPTH, RWKV_WIDTH), 0.1),
        'rwkv_gn_w': 1.0 + nrm(ks[19], (DEPTH, RWKV_WIDTH), 0.05),
        'rwkv_gn_b': nrm(ks[20], (DEPTH, RWKV_WIDTH), 0.02),
        'attn_sink': nrm(ks[21], (DEPTH, ATT_HEADS), 0.5),
        'rel_pos_table': nrm(ks[22], (N_BUCKETS, ATT_HEADS), 0.5),
        'w_branch': nrm(ks[23], (DEPTH, N_BRANCH, BRANCH_WIDTH, D_MODEL), BRANCH_WIDTH ** -0.5),
        'w_out': nrm(ks[24], (DEPTH, D_MODEL, D_MODEL), 0.5 * D_MODEL ** -0.5),
        'final_norm_g': 1.0 + nrm(ks[25], (D_MODEL,), 0.05),
    }


def reference(x_prompt, x_sample, cache_attn_k, cache_attn_v, state_rwkv, state_rwkv_shift, state_pool,
              norm_g, w_in, pool_w, pool_scale, rwkv_mu, rwkv_w0, rwkv_w_up, rwkv_a0, rwkv_a_up, rwkv_k_k,
              rwkv_k_a, rwkv_r_k, rwkv_gn_w, rwkv_gn_b, attn_sink, rel_pos_table, w_branch, w_out, final_norm_g):
    bp = x_prompt.shape[0]
    rel_p = (jnp.arange(BAND_KEYS) - BAND_CHUNKS * CHUNK)[None, :] - jnp.arange(CHUNK)[:, None]
    bias_p = rel_bias(rel_pos_table, rel_p)
    n_cache = cache_attn_k.shape[2]
    t_s = x_sample.shape[1]
    key_s = jnp.concatenate([jnp.arange(n_cache) - n_cache, jnp.arange(t_s)])
    bias_s = rel_bias(rel_pos_table, key_s[None, :] - jnp.arange(t_s)[:, None])

    xp, xs = x_prompt, x_sample
    kp_l, vp_l, sp_l, shp_l, plp_l = [], [], [], [], []
    ks_l, vs_l, ss_l, shs_l, pls_l = [], [], [], [], []
    for l in range(DEPTH):
        lw = (norm_g[l], w_in[l], pool_w[l], pool_scale[l], rwkv_mu[l], rwkv_w0[l], rwkv_w_up[l], rwkv_a0[l],
              rwkv_a_up[l], rwkv_k_k[l], rwkv_k_a[l], rwkv_r_k[l], rwkv_gn_w[l], rwkv_gn_b[l], w_branch[l], w_out[l])
        attn_p = functools.partial(swa_prompt, sink=attn_sink[l], bias=bias_p)
        xp, kp, vp, sp, shp, plp = mixer_layer(
            xp, 0, jnp.zeros((bp, POOL_HIST, POOL_WIDTH), xp.dtype), jnp.zeros((bp, SHIFT_WIDTH), xp.dtype),
            jnp.zeros((bp, RWKV_HEADS, RWKV_HEAD, RWKV_HEAD), jnp.float32), attn_p, *lw)
        kp_l.append(kp[:, -WINDOW:]); vp_l.append(vp[:, -WINDOW:])
        sp_l.append(sp); shp_l.append(shp); plp_l.append(plp)
        attn_s = functools.partial(swa_sample, k_cache=cache_attn_k[l], v_cache=cache_attn_v[l],
                                   sink=attn_sink[l], bias=bias_s)
        xs, k_s, v_s, s_s, sh_s, pl_s = mixer_layer(
            xs, PAST_LEN, state_pool[l], state_rwkv_shift[l], state_rwkv[l], attn_s, *lw)
        ks_l.append(k_s); vs_l.append(v_s); ss_l.append(s_s); shs_l.append(sh_s); pls_l.append(pl_s)

    y_prompt = rms_norm(xp, final_norm_g)
    y_sample = rms_norm(xs, final_norm_g)
    return (y_prompt, y_sample,
            jnp.stack(kp_l), jnp.stack(vp_l), jnp.stack(ks_l), jnp.stack(vs_l),
            jnp.stack(sp_l), jnp.stack(ss_l), jnp.stack(shp_l), jnp.stack(shs_l),
            jnp.stack(plp_l), jnp.stack(pls_l))
```

```cpp
#include <hip/hip_runtime.h>
#include <hip/hip_cooperative_groups.h>
#include <cstdio>
#include <type_traits>
namespace cg = cooperative_groups;

#define LAS __attribute__((address_space(3)))
typedef unsigned short u16;
typedef short bf16x8 __attribute__((ext_vector_type(8)));
typedef float f32x4 __attribute__((ext_vector_type(4)));
typedef float f32x16 __attribute__((ext_vector_type(16)));
typedef unsigned u32x4 __attribute__((ext_vector_type(4)));
typedef unsigned u32x2 __attribute__((ext_vector_type(2)));

constexpr int D = 2048, MP = 16384, MS = 256, M = MP + MS;
constexpr int NIN = 14976, NIN_PAD = 15104;
constexpr int OFF_POOL = 0, OFF_SHIFT = 1024, OFF_Q = 4224, OFF_K = 5248, OFF_V = 5504, OFF_GATE = 5760, OFF_MERGE = 8832;
constexpr int SHIFT_W = 3200;
constexpr size_t O_YP = 0, O_YS = O_YP + (size_t)MP * D, O_KP = O_YS + (size_t)MS * D, O_VP = O_KP + 2 * 4 * 128 * 256, O_KS = O_VP + 2 * 4 * 128 * 256,
                 O_VS = O_KS + 2 * 16 * 16 * 256, O_RP = O_VS + 2 * 16 * 16 * 256, O_RS = O_RP + 2 * 4 * 16 * 4096, O_SHP = O_RS + 2 * 16 * 16 * 4096,
                 O_SHS = O_SHP + 2 * 4 * 3200, O_PLP = O_SHS + 2 * 16 * 3200, O_PLS = O_PLP + 2 * 4 * 15 * 1024, O_END = O_PLS + 2 * 16 * 15 * 1024;
constexpr size_t WS_CTL = 0, WS_WTIN = 4096, WS_WTBR = WS_WTIN + (size_t)2 * NIN_PAD * 2048 * 2, WS_WTOUT = WS_WTBR + (size_t)2 * 3 * 2048 * 1024 * 2,
                 WS_WTPOOL = WS_WTOUT + (size_t)2 * 2048 * 2048 * 2, WS_WUPT = WS_WTPOOL + (size_t)2 * 4 * 256 * 256 * 2, WS_AUPT = WS_WUPT + (size_t)2 * 1024 * 64 * 2,
                 WS_H = WS_AUPT + (size_t)2 * 1024 * 64 * 2, WS_PROJ = WS_H + (size_t)M * 2048 * 2, WS_DEC = WS_PROJ + (size_t)M * NIN * 2,
                 WS_AA = WS_DEC + (size_t)M * 1024 * 4, WS_YRAW = WS_AA + (size_t)M * 1024 * 4, WS_END = WS_YRAW + (size_t)M * 1024 * 4;
#ifndef PROBE
#define PROBE 0
#endif
#ifndef PH_MASK
#define PH_MASK 0xFFFF
#endif
constexpr int LDS_BYTES = 131072 + 512;

struct Params { const float* in[26]; float* out; unsigned char* ws; };

__device__ __forceinline__ unsigned pk_bf16(float lo, float hi) { unsigned r; asm("v_cvt_pk_bf16_f32 %0, %1, %2" : "=v"(r) : "v"(lo), "v"(hi)); return r; }
__device__ __forceinline__ u16 f2bf(float x) { return (u16)(pk_bf16(x, 0.f) & 0xffffu); }
__device__ __forceinline__ float bf2f(u16 x) { return __uint_as_float(((unsigned)x) << 16); }
__device__ __forceinline__ float lo_bf(unsigned w) { return __uint_as_float(w << 16); }
__device__ __forceinline__ float hi_bf(unsigned w) { return __uint_as_float(w & 0xffff0000u); }
__device__ __forceinline__ float sigm(float x) { return __builtin_amdgcn_rcpf(1.f + __expf(-x)); }
__device__ __forceinline__ int opaque_tid() {
    extern __shared__ __attribute__((aligned(16))) unsigned char smem_all[];
    const int key = __builtin_amdgcn_s_getreg(10244) & 63;
    int wv = ((const volatile int*)(smem_all + 131072 + 256))[key];
    wv = __builtin_amdgcn_readfirstlane(wv);
    int t = (wv << 6) | (int)__builtin_amdgcn_mbcnt_hi(~0u, __builtin_amdgcn_mbcnt_lo(~0u, 0u));
    asm volatile("" : "+v"(t)); return t; }
template <int CTRL> __device__ __forceinline__ float dppf(float x) { return __int_as_float(__builtin_amdgcn_update_dpp(0, __float_as_int(x), CTRL, 0xF, 0xF, true)); }
__device__ __forceinline__ float wave_sum(float x) {
    x += dppf<0xB1>(x); x += dppf<0x4E>(x); x += dppf<0x141>(x); x += dppf<0x140>(x);
    x += __int_as_float(__builtin_amdgcn_update_dpp(0, __float_as_int(x), 0x142, 0xA, 0xF, false));
    x += __int_as_float(__builtin_amdgcn_update_dpp(0, __float_as_int(x), 0x143, 0xC, 0xF, false));
    return __int_as_float(__builtin_amdgcn_readlane(__float_as_int(x), 63));
}
__device__ __forceinline__ float red8(float x) { x += dppf<0xB1>(x); x += dppf<0x4E>(x); x += dppf<0x141>(x); return x; }
__device__ __forceinline__ void unpack8(u32x4 w, float* f) {
    f[0] = lo_bf(w.x); f[1] = hi_bf(w.x); f[2] = lo_bf(w.y); f[3] = hi_bf(w.y); f[4] = lo_bf(w.z); f[5] = hi_bf(w.z); f[6] = lo_bf(w.w); f[7] = hi_bf(w.w);
}

__device__ __forceinline__ void tr_cvt(const float* __restrict__ src, int K, int N, u16* __restrict__ dst, int& base, float* tile) {
    const int tid = opaque_tid();
    const int tn = N >> 7, tk = K >> 6, nt = tn * tk;
    const int G = gridDim.x;
    const int start = (int)((blockIdx.x + G - (base % G)) % G);
    for (int t = start; t < nt; t += G) {
        const int k0 = (t / tn) << 6, n0 = (t % tn) << 7;
        __syncthreads();
        {
            const int r = tid >> 5, c = (tid & 31) << 2;
            f32x4 v[4];
#pragma unroll
            for (int q = 0; q < 4; ++q) v[q] = *(const f32x4*)(src + (size_t)(k0 + r + q * 16) * N + n0 + c);
#pragma unroll
            for (int q = 0; q < 4; ++q)
#pragma unroll
                for (int e = 0; e < 4; ++e) tile[(r + q * 16) * 129 + c + e] = v[q][e];
        }
        __syncthreads();
        {
            const int n = tid >> 2, k16 = (tid & 3) << 4;
            float v[16];
#pragma unroll
            for (int e = 0; e < 16; ++e) v[e] = tile[(k16 + e) * 129 + n];
            u32x4 w0, w1;
            w0.x = pk_bf16(v[0], v[1]); w0.y = pk_bf16(v[2], v[3]); w0.z = pk_bf16(v[4], v[5]); w0.w = pk_bf16(v[6], v[7]);
            w1.x = pk_bf16(v[8], v[9]); w1.y = pk_bf16(v[10], v[11]); w1.z = pk_bf16(v[12], v[13]); w1.w = pk_bf16(v[14], v[15]);
            u16* dp = dst + (size_t)(n0 + n) * K + k0 + k16;
            *(u32x4*)dp = w0; *(u32x4*)(dp + 8) = w1;
        }
    }
    base += nt;
}

template <bool TO_BF16>
__device__ __forceinline__ void rms_rows(const float* xp, const float* xs, const float* __restrict__ g, u16* h, float* yo) {
    const int tid_ = opaque_tid(); const int wid = tid_ >> 6, lane = tid_ & 63;
    const int stride = gridDim.x * 8;
    for (int row0 = blockIdx.x * 8 + wid; row0 < M; row0 += 2 * stride) {
        const int rowB = row0 + stride; const bool hasB = rowB < M;
        const float* srcA = row0 < MP ? xp + (size_t)row0 * D : xs + (size_t)(row0 - MP) * D;
        const float* srcB = hasB ? (rowB < MP ? xp + (size_t)rowB * D : xs + (size_t)(rowB - MP) * D) : srcA;
        f32x4 va[8], vb[8]; float sa = 0.f, sb = 0.f;
#pragma unroll
        for (int i = 0; i < 8; ++i) { va[i] = *(const f32x4*)(srcA + i * 256 + lane * 4); vb[i] = *(const f32x4*)(srcB + i * 256 + lane * 4); }
#pragma unroll
        for (int i = 0; i < 8; ++i) { sa += va[i][0] * va[i][0] + va[i][1] * va[i][1] + va[i][2] * va[i][2] + va[i][3] * va[i][3];
                                      sb += vb[i][0] * vb[i][0] + vb[i][1] * vb[i][1] + vb[i][2] * vb[i][2] + vb[i][3] * vb[i][3]; }
        sa = wave_sum(sa); sb = wave_sum(sb);
        const float ra = rsqrtf(sa * (1.0f / D) + 1e-6f), rb = rsqrtf(sb * (1.0f / D) + 1e-6f);
#pragma unroll
        for (int i = 0; i < 8; ++i) {
            const f32x4 gg = *(const f32x4*)(g + i * 256 + lane * 4);
            f32x4 oa, ob;
#pragma unroll
            for (int e = 0; e < 4; ++e) { oa[e] = va[i][e] * ra * gg[e]; ob[e] = vb[i][e] * rb * gg[e]; }
            if (TO_BF16) {
                u32x2 w; w.x = pk_bf16(oa[0], oa[1]); w.y = pk_bf16(oa[2], oa[3]); *(u32x2*)(h + (size_t)row0 * D + i * 256 + lane * 4) = w;
                if (hasB) { w.x = pk_bf16(ob[0], ob[1]); w.y = pk_bf16(ob[2], ob[3]); *(u32x2*)(h + (size_t)rowB * D + i * 256 + lane * 4) = w; }
            } else {
                *(f32x4*)(yo + (size_t)row0 * D + i * 256 + lane * 4) = oa;
                if (hasB) *(f32x4*)(yo + (size_t)rowB * D + i * 256 + lane * 4) = ob;
            }
        }
    }
}

constexpr int BM = 256, BK = 64, HALF = 128, HTB = HALF * BK * 2;
__device__ __forceinline__ int lds_byte(int r, int c) { const int st = (r >> 4) * 2 + (c >> 5), rr = r & 15, cc = c & 31, ob = rr * 64 + cc * 2; return st * 1024 + (ob ^ (((ob >> 9) & 1) << 5)); }
__device__ __forceinline__ void stage_rc(int b, int& R, int& C) { const int st = b / 1024, sb = b % 1024, swz = sb ^ (((sb >> 9) & 1) << 5); R = (st >> 1) * 16 + swz / 64; C = (st & 1) * 32 + (swz % 64) / 2; }
__device__ __forceinline__ int perm32(int rho) { const int n = rho >> 4, i = rho & 15; return 8 * (i >> 2) + 4 * n + (i & 3); }
struct Unit { int pm, pn, z; };

template <class Epi, class Sched>
__device__ __forceinline__ void gemm_phase(LAS unsigned char* lds, const int K, const int lda, Sched& S, const Epi& E) {
    const int tid = opaque_tid(), wid = __builtin_amdgcn_readfirstlane(tid >> 6), lane = tid & 63, wr = wid >> 2, wc = wid & 3, fr = lane & 15, fq = lane >> 4;
    const int nt = K / BK;
    unsigned voffA[2], voffB[2];
#pragma unroll
    for (int i = 0; i < 2; ++i) { int R, C; stage_rc(tid * 16 + i * 8192, R, C); const int Rb = (R & ~31) + perm32(R & 31);
        voffA[i] = (unsigned)(R * lda + C) * 2u; voffB[i] = (unsigned)(Rb * K + C) * 2u; }
    const size_t kstep = (size_t)(BK * 2);
    const size_t hstepA = (size_t)HALF * lda * 2, hstepB = (size_t)HALF * K * 2;
    const unsigned ldsw = (unsigned)wid * 1024u;
    const int aoff = lds_byte(wr * 64 + fr, fq * 8), boff = lds_byte(wc * 32 + fr, fq * 8);
#define PG8_SA(b, h) (((b) * 2 + (h)) * HTB)
#define PG8_SB(b, h) ((4 + (b) * 2 + (h)) * HTB)
#define PG8_STAGE(bufoff, gbase, voff) do { _Pragma("unroll") for (int _i = 0; _i < 2; ++_i) \
        __builtin_amdgcn_global_load_lds((const unsigned*)((const char*)(gbase) + (voff)[_i]), (LAS unsigned*)(lds + (bufoff) + ldsw + _i * 8192), 16, 0, 0); } while (0)
#define PG8_LDA(dst, b, h) do { _Pragma("unroll") for (int m = 0; m < 4; ++m) _Pragma("unroll") for (int k = 0; k < 2; ++k) dst[m][k] = *(const LAS bf16x8*)(lds + PG8_SA(b, h) + aoff + m * 2048 + k * 1024); } while (0)
#define PG8_LDB(dst, b, h) do { _Pragma("unroll") for (int n = 0; n < 2; ++n) _Pragma("unroll") for (int k = 0; k < 2; ++k) dst[n][k] = *(const LAS bf16x8*)(lds + PG8_SB(b, h) + boff + n * 2048 + k * 1024); } while (0)
#define PG8_MMA(ai, bj, At, Bt) do { __builtin_amdgcn_s_setprio(1); _Pragma("unroll") for (int m = 0; m < 4; ++m) _Pragma("unroll") for (int n = 0; n < 2; ++n) _Pragma("unroll") for (int k = 0; k < 2; ++k) \
        acc[ai][bj][m][n] = __builtin_amdgcn_mfma_f32_16x16x32_bf16(Bt[n][k], At[m][k], acc[ai][bj][m][n], 0, 0, 0); __builtin_amdgcn_s_setprio(0); } while (0)
#define PG8_WAIT_V(n) asm volatile("s_waitcnt vmcnt(" #n ")" ::: "memory")
#define PG8_WAIT_L(n) asm volatile("s_waitcnt lgkmcnt(" #n ")" ::: "memory")
#define PG8_BAR __builtin_amdgcn_s_barrier()
#define PG8_SCHED __builtin_amdgcn_sched_barrier(0)
    Unit cur, nxt; int ui = 0;
    if (!S.next(0, cur)) return;
    f32x4 acc[2][2][4][2];
#pragma unroll
    for (int a = 0; a < 2; ++a)
#pragma unroll
        for (int b = 0; b < 2; ++b)
#pragma unroll
            for (int m = 0; m < 4; ++m)
#pragma unroll
                for (int n = 0; n < 2; ++n) acc[a][b][m][n] = (f32x4){0.f, 0.f, 0.f, 0.f};
    bf16x8 At[4][2], B0[2][2], B1[2][2];
    const char* cA = S.aptr(cur); const char* cB = S.bptr(cur);
    PG8_STAGE(PG8_SB(0, 0), cB, voffB); PG8_STAGE(PG8_SA(0, 0), cA, voffA); PG8_STAGE(PG8_SB(0, 1), cB + hstepB, voffB); PG8_STAGE(PG8_SA(0, 1), cA + hstepA, voffA);
    if (wr == 1) PG8_BAR;
    PG8_WAIT_V(4); PG8_BAR;
    PG8_STAGE(PG8_SB(1, 0), cB + kstep, voffB); PG8_STAGE(PG8_SA(1, 0), cA + kstep, voffA); PG8_STAGE(PG8_SB(1, 1), cB + hstepB + kstep, voffB);
    PG8_WAIT_V(6); PG8_BAR;
    for (;;) {
        const bool has_next = S.next(ui + 1, nxt);
        const char* nA = has_next ? S.aptr(nxt) : cA; const char* nB = has_next ? S.bptr(nxt) : cB;
        for (int t = 0; t < nt; t += 2) {
            const bool last = (t == nt - 2);
            const char* a1 = cA + (size_t)(t + 1) * kstep;
            const char* a2 = last ? nA : cA + (size_t)(t + 2) * kstep; const char* b2 = last ? nB : cB + (size_t)(t + 2) * kstep;
            const char* a3 = a2 + kstep; const char* b3 = b2 + kstep;
            PG8_LDB(B0, 0, 0); PG8_SCHED; PG8_LDA(At, 0, 0); PG8_STAGE(PG8_SA(1, 1), a1 + hstepA, voffA);
            PG8_WAIT_L(8); PG8_BAR; PG8_WAIT_L(0); PG8_MMA(0, 0, At, B0); PG8_BAR; PG8_SCHED;
            PG8_LDB(B1, 0, 1); PG8_STAGE(PG8_SB(0, 0), b2, voffB);
            PG8_BAR; PG8_WAIT_L(0); PG8_MMA(0, 1, At, B1); PG8_BAR;
            PG8_LDA(At, 0, 1); PG8_STAGE(PG8_SA(0, 0), a2, voffA);
            PG8_BAR; PG8_WAIT_L(0); PG8_MMA(1, 0, At, B0); PG8_BAR; PG8_SCHED;
            PG8_STAGE(PG8_SB(0, 1), b2 + hstepB, voffB);
            PG8_WAIT_V(6); PG8_BAR; PG8_MMA(1, 1, At, B1); PG8_BAR;
            PG8_LDB(B0, 1, 0); PG8_SCHED; PG8_LDA(At, 1, 0); PG8_STAGE(PG8_SA(0, 1), a2 + hstepA, voffA);
            PG8_WAIT_L(8); PG8_BAR; PG8_WAIT_L(0); PG8_MMA(0, 0, At, B0); PG8_BAR; PG8_SCHED;
            PG8_LDB(B1, 1, 1); PG8_STAGE(PG8_SB(1, 0), b3, voffB);
            PG8_BAR; PG8_WAIT_L(0); PG8_MMA(0, 1, At, B1); PG8_BAR;
            PG8_LDA(At, 1, 1); PG8_STAGE(PG8_SA(1, 0), a3, voffA);
            PG8_BAR; PG8_WAIT_L(0); PG8_MMA(1, 0, At, B0); PG8_BAR; PG8_SCHED;
            PG8_STAGE(PG8_SB(1, 1), b3 + hstepB, voffB);
            PG8_WAIT_V(6); PG8_BAR; PG8_MMA(1, 1, At, B1); PG8_BAR;
        }
        E(acc, cur, wr, wc, fr, fq);
        if (!has_next) break;
        if (E.zero_after(cur))
#pragma unroll
        for (int a = 0; a < 2; ++a)
#pragma unroll
            for (int b = 0; b < 2; ++b)
#pragma unroll
                for (int m = 0; m < 4; ++m)
#pragma unroll
                    for (int n = 0; n < 2; ++n) acc[a][b][m][n] = (f32x4){0.f, 0.f, 0.f, 0.f};
        cur = nxt; cA = nA; cB = nB; ++ui;
    }
    PG8_WAIT_V(0);
    if (wr == 0) PG8_BAR;
    PG8_BAR;
#undef PG8_SA
#undef PG8_SB
#undef PG8_STAGE
#undef PG8_LDA
#undef PG8_LDB
#undef PG8_MMA
#undef PG8_WAIT_V
#undef PG8_WAIT_L
#undef PG8_BAR
#undef PG8_SCHED
}

__device__ __forceinline__ int xcd_remap(int L, int nwg) {
    const int q = nwg >> 3, r = nwg & 7, xcd = L & 7, off = L >> 3;
    return (xcd < r ? xcd * (q + 1) : r * (q + 1) + (xcd - r) * q) + off;
}
__device__ __forceinline__ void map_tile(int L, int nq, int nM, int& pm, int& q) {
    const int nig = 8 * nq, gid = L / nig, fm = gid * 8, gsz = (nM - fm) < 8 ? (nM - fm) : 8;
    pm = fm + ((L % nig) % gsz); q = (L % nig) / gsz;
}
struct SchedIn {
    const u16* A; const u16* Bt; int set; unsigned* ctr; LAS int* slot; int G, c; int steal; bool t0;
    __device__ __forceinline__ bool next(int i, Unit& u) {
        const int nq = set == 0 ? 18 : 41, nwg = 65 * nq;
        int L;
        if (ctr) {
            if (t0) {
                const int q8 = nwg >> 3, r8 = nwg & 7;
                int res = nwg;
                while (steal < 8) {
                    const int x = (c + steal) & 7;
                    const int cnt = q8 + (x < r8 ? 1 : 0), base = x < r8 ? x * (q8 + 1) : r8 * (q8 + 1) + (x - r8) * q8;
                    const int v = (int)atomicAdd(ctr + x, 1u);
                    if (v < cnt) { res = base + v; break; }
                    ++steal;
                }
                slot[i & 1] = res; asm volatile("s_waitcnt lgkmcnt(0)" ::: "memory");
            }
            __builtin_amdgcn_s_barrier();
            asm volatile("" ::: "memory");
            L = slot[i & 1];
            if (L >= nwg) return false;
        } else { L = i * G + c; if (L >= nwg) return false; L = xcd_remap(L, nwg); }
        int q; map_tile(L, nq, 65, u.pm, q);
        if (set == 0) u.pn = q < 13 ? 4 + q : 26 + (q - 13);
        else u.pn = q < 4 ? q : (q < 13 ? 17 + (q - 4) : 31 + (q - 13));
        u.z = 0; return true;
    }
    __device__ __forceinline__ const char* aptr(const Unit& u) const { return (const char*)(A + (size_t)u.pm * 256 * 2048); }
    __device__ __forceinline__ const char* bptr(const Unit& u) const { return (const char*)(Bt + (size_t)u.pn * 256 * 2048); }
};
struct SchedBr {
    const u16* A; const u16* Bt; int G, c;
    __device__ __forceinline__ bool next(int i, Unit& u) {
        int L = (i / 3) * G + c; if (L >= 64 * 8) return false;
        L = xcd_remap(L, 64 * 8);
        map_tile(L, 8, 64, u.pm, u.pn); u.z = i % 3; return true;
    }
    __device__ __forceinline__ const char* aptr(const Unit& u) const { return (const char*)(A + (size_t)u.pm * 256 * NIN + OFF_GATE + u.z * 1024); }
    __device__ __forceinline__ const char* bptr(const Unit& u) const { return (const char*)(Bt + (size_t)u.z * 2048 * 1024 + (size_t)u.pn * 256 * 1024); }
};
struct SchedBrDense {
    const u16* A; const u16* Bt; int G, c;
    __device__ __forceinline__ bool next(int i, Unit& u) {
        int L = (i / 3) * G + c; if (L >= 64 * 8) return false;
        L = xcd_remap(L, 64 * 8);
        map_tile(L, 8, 64, u.pm, u.pn); u.z = i % 3; return true;
    }
    __device__ __forceinline__ const char* aptr(const Unit& u) const { return (const char*)(A + (size_t)u.pm * 256 * 2048 + (u.z & 1) * 1024); }
    __device__ __forceinline__ const char* bptr(const Unit& u) const { return (const char*)(Bt + (size_t)u.z * 2048 * 1024 + (size_t)u.pn * 256 * 1024); }
};
struct SchedOut {
    const u16* A; const u16* Bt; int G, c;
    __device__ __forceinline__ bool next(int i, Unit& u) {
        int L = i * G + c; if (L >= 64 * 8) return false;
        L = xcd_remap(L, 64 * 8);
        map_tile(L, 8, 64, u.pm, u.pn); u.z = 0; return true;
    }
    __device__ __forceinline__ const char* aptr(const Unit& u) const { return (const char*)(A + (size_t)u.pm * 256 * 2048); }
    __device__ __forceinline__ const char* bptr(const Unit& u) const { return (const char*)(Bt + (size_t)u.pn * 256 * 2048); }
};

struct EpiIn {
    u16* proj; bool dry = false;
    __device__ __forceinline__ bool zero_after(const Unit&) const { return true; }
    __device__ __forceinline__ void operator()(f32x4 (&acc)[2][2][4][2], const Unit& u, int wr, int wc, int fr, int fq) const {
#pragma unroll
        for (int bj = 0; bj < 2; ++bj) {
            const int colb = u.pn * 256 + bj * 128;
            if (colb >= NIN) continue;
            const int act = colb >= OFF_MERGE ? 2 : (colb >= OFF_GATE ? 1 : 0);
            u16* pb = proj + (size_t)(u.pm * 256 + wr * 64 + fr) * NIN + colb + wc * 32 + 8 * fq;
#pragma unroll
            for (int ai = 0; ai < 2; ++ai)
#pragma unroll
                for (int m = 0; m < 4; ++m) {
                    f32x4 v0 = acc[ai][bj][m][0], v1 = acc[ai][bj][m][1];
                    if (act == 1) {
#pragma unroll
                        for (int j = 0; j < 4; ++j) { v0[j] = v0[j] * sigm(v0[j]); v1[j] = v1[j] * sigm(v1[j]); }
                    } else if (act == 2) {
#pragma unroll
                        for (int j = 0; j < 4; ++j) { v0[j] = sigm(v0[j]); v1[j] = sigm(v1[j]); }
                    }
                    u32x4 w; w.x = pk_bf16(v0[0], v0[1]); w.y = pk_bf16(v0[2], v0[3]); w.z = pk_bf16(v1[0], v1[1]); w.w = pk_bf16(v1[2], v1[3]);
                    if (!dry || w.x == 0x12345u) *(u32x4*)(pb + (size_t)(ai * 128 + m * 16) * NIN) = w;
                }
        }
    }
};
__device__ __forceinline__ void side_outputs(const Params& P, int l, int nblk, int blk) {
    const u16* proj = (const u16*)(P.ws + WS_PROJ);
    float* out = P.out;
    const int nthr = nblk * 512, gt = blk * 512 + opaque_tid();
    for (int i = gt; i < 4 * 15 * 1024; i += nthr) { const int c = i & 1023, j = (i >> 10) % 15, b = i / (15 * 1024);
        out[O_PLP + (size_t)l * 4 * 15 * 1024 + i] = bf2f(proj[((size_t)b * 4096 + 4081 + j) * NIN + c]); }
    for (int i = gt; i < 16 * 15 * 1024; i += nthr) { const int c = i & 1023, j = (i >> 10) % 15, b = i / (15 * 1024);
        out[O_PLS + (size_t)l * 16 * 15 * 1024 + i] = bf2f(proj[((size_t)MP + b * 16 + 1 + j) * NIN + c]); }
    for (int i = gt; i < 4 * SHIFT_W; i += nthr) { const int c = i % SHIFT_W, b = i / SHIFT_W;
        out[O_SHP + (size_t)l * 4 * SHIFT_W + i] = bf2f(proj[((size_t)b * 4096 + 4095) * NIN + OFF_SHIFT + c]); }
    for (int i = gt; i < 16 * SHIFT_W; i += nthr) { const int c = i % SHIFT_W, b = i / SHIFT_W;
        out[O_SHS + (size_t)l * 16 * SHIFT_W + i] = bf2f(proj[((size_t)MP + b * 16 + 15) * NIN + OFF_SHIFT + c]); }
    for (int i = gt; i < 4 * 128 * 256; i += nthr) { const int c = i & 255, t = (i >> 8) & 127, b = i >> 15;
        const size_t r = ((size_t)b * 4096 + 3968 + t) * NIN;
        out[O_KP + (size_t)l * 4 * 128 * 256 + i] = bf2f(proj[r + OFF_K + c]); out[O_VP + (size_t)l * 4 * 128 * 256 + i] = bf2f(proj[r + OFF_V + c]); }
    for (int i = gt; i < 16 * 16 * 256; i += nthr) { const int c = i & 255, t = (i >> 8) & 15, b = i >> 12;
        const size_t r = ((size_t)MP + b * 16 + t) * NIN;
        out[O_KS + (size_t)l * 16 * 16 * 256 + i] = bf2f(proj[r + OFF_K + c]); out[O_VS + (size_t)l * 16 * 16 * 256 + i] = bf2f(proj[r + OFF_V + c]); }
}
struct EpiBr {
    const u16* proj; u16* merged;
    __device__ __forceinline__ bool zero_after(const Unit& u) const { return u.z == 2; }
    __device__ __forceinline__ void operator()(f32x4 (&acc)[2][2][4][2], const Unit& u, int wr, int wc, int fr, int fq) const {
        const int b = u.z;
        const u16* gbase = proj + (size_t)(u.pm * 256 + wr * 64 + fr) * NIN + OFF_MERGE + b * 2048 + u.pn * 256 + wc * 32 + 8 * fq;
        u16* mbase = merged + (size_t)(u.pm * 256 + wr * 64 + fr) * 2048 + u.pn * 256 + wc * 32 + 8 * fq;
#pragma unroll
        for (int ai = 0; ai < 2; ++ai) {
            u32x4 g[4][2], gn[4][2];
#pragma unroll
            for (int m = 0; m < 4; ++m)
#pragma unroll
                for (int bj = 0; bj < 2; ++bj) {
                    const u16* gp = gbase + (size_t)(ai * 128 + m * 16) * NIN + bj * 128;
                    g[m][bj] = *(const u32x4*)gp;
                    if (b < 2) gn[m][bj] = *(const u32x4*)(gp + 2048);
                }
#pragma unroll
            for (int m = 0; m < 4; ++m)
#pragma unroll
                for (int bj = 0; bj < 2; ++bj) {
                    float gf[8]; unpack8(g[m][bj], gf);
                    if (b < 2) {
                        float gd[8]; unpack8(gn[m][bj], gd);
#pragma unroll
                        for (int j = 0; j < 8; ++j) gf[j] = fmaxf(gf[j], 1e-20f) * __builtin_amdgcn_rcpf(fmaxf(gd[j], 1e-20f));
                    } else {
#pragma unroll
                        for (int j = 0; j < 8; ++j) gf[j] = fmaxf(gf[j], 1e-20f);
                    }
#pragma unroll
                    for (int j = 0; j < 4; ++j) { acc[ai][bj][m][0][j] *= gf[j]; acc[ai][bj][m][1][j] *= gf[4 + j]; }
                    if (b == 2) {
                        const f32x4 v0 = acc[ai][bj][m][0], v1 = acc[ai][bj][m][1];
                        u32x4 w; w.x = pk_bf16(v0[0], v0[1]); w.y = pk_bf16(v0[2], v0[3]); w.z = pk_bf16(v1[0], v1[1]); w.w = pk_bf16(v1[2], v1[3]);
                        *(u32x4*)(mbase + (size_t)(ai * 128 + m * 16) * 2048 + bj * 128) = w;
                    }
                }
        }
    }
};
struct EpiOut {
    const float* xp; const float* xs; float* out;
    __device__ __forceinline__ bool zero_after(const Unit&) const { return true; }
    __device__ __forceinline__ void operator()(f32x4 (&acc)[2][2][4][2], const Unit& u, int wr, int wc, int fr, int fq) const {
        const int r0 = u.pm * 256 + wr * 64 + fr, c0 = u.pn * 256 + wc * 32 + 8 * fq;
        const float* src = (r0 < MP ? xp + (size_t)r0 * D : xs + (size_t)(r0 - MP) * D) + c0;
        float* dst = out + (size_t)r0 * D + c0;
#pragma unroll
        for (int ai = 0; ai < 2; ++ai) {
            f32x4 x[4][2][2];
#pragma unroll
            for (int m = 0; m < 4; ++m)
#pragma unroll
                for (int bj = 0; bj < 2; ++bj) {
                    const float* sp = src + (size_t)(ai * 128 + m * 16) * D + bj * 128;
                    x[m][bj][0] = *(const f32x4*)sp; x[m][bj][1] = *(const f32x4*)(sp + 4);
                }
#pragma unroll
            for (int m = 0; m < 4; ++m)
#pragma unroll
                for (int bj = 0; bj < 2; ++bj) {
                    float* dp = dst + (size_t)(ai * 128 + m * 16) * D + bj * 128;
                    *(f32x4*)dp = x[m][bj][0] + acc[ai][bj][m][0];
                    *(f32x4*)(dp + 4) = x[m][bj][1] + acc[ai][bj][m][1];
                }
        }
    }
};

template <int K>
__device__ __forceinline__ f32x4 small_pass(const u16* A, int lda, const u16* Bt, unsigned char* smem) {
    const int tid = opaque_tid(), w = tid >> 6, lane = tid & 63, fr = lane & 15, fq = lane >> 4;
    float* red = (float*)smem;
    constexpr int kp = K >> 3; const int k0 = w * kp;
    f32x4 acc[2][4];
#pragma unroll
    for (int a = 0; a < 2; ++a)
#pragma unroll
        for (int b = 0; b < 4; ++b) acc[a][b] = (f32x4){0.f, 0.f, 0.f, 0.f};
#pragma unroll
    for (int ks = 0; ks < (kp >> 5); ++ks) {
        const int kk = k0 + ks * 32 + fq * 8;
        bf16x8 af[2], bfr[4];
#pragma unroll
        for (int mb = 0; mb < 2; ++mb) af[mb] = *(const bf16x8*)(A + (size_t)(mb * 16 + fr) * lda + kk);
#pragma unroll
        for (int nb = 0; nb < 4; ++nb) bfr[nb] = *(const bf16x8*)(Bt + (size_t)(nb * 16 + fr) * K + kk);
#pragma unroll
        for (int mb = 0; mb < 2; ++mb)
#pragma unroll
            for (int nb = 0; nb < 4; ++nb) acc[mb][nb] = __builtin_amdgcn_mfma_f32_16x16x32_bf16(bfr[nb], af[mb], acc[mb][nb], 0, 0, 0);
    }
    __syncthreads();
#pragma unroll
    for (int mb = 0; mb < 2; ++mb)
#pragma unroll
        for (int nb = 0; nb < 4; ++nb) *(f32x4*)(red + w * 2048 + (mb * 16 + fr) * 64 + nb * 16 + fq * 4) = acc[mb][nb];
    __syncthreads();
    f32x4 s = {0.f, 0.f, 0.f, 0.f};
#pragma unroll
    for (int ww = 0; ww < 8; ++ww) s += *(const f32x4*)(red + ww * 2048 + tid * 4);
    return s;
}
__device__ __forceinline__ void branch_small(const Params& P, int l, int tile, unsigned char* smem) {
    const int tid = opaque_tid();
    const int R0 = MP + (tile & 7) * 32, N0 = (tile >> 3) * 64;
    const u16* proj = (const u16*)(P.ws + WS_PROJ);
    const u16* wtbr = (const u16*)(P.ws + WS_WTBR) + (size_t)l * 3 * 2048 * 1024;
    const int row = R0 + (tid >> 4), col = N0 + (tid & 15) * 4;
    f32x4 tot = {0.f, 0.f, 0.f, 0.f};
#pragma unroll 1
    for (int z = 0; z < 3; ++z) {
        const f32x4 s = small_pass<1024>(proj + (size_t)R0 * NIN + OFF_GATE + z * 1024, NIN, wtbr + (size_t)z * 2048 * 1024 + (size_t)N0 * 1024, smem);
        const u32x2 g = *(const u32x2*)(proj + (size_t)row * NIN + OFF_MERGE + z * 2048 + col);
        tot[0] += lo_bf(g.x) * s[0]; tot[1] += hi_bf(g.x) * s[1]; tot[2] += lo_bf(g.y) * s[2]; tot[3] += hi_bf(g.y) * s[3];
    }
    u32x2 o; o.x = pk_bf16(tot[0], tot[1]); o.y = pk_bf16(tot[2], tot[3]);
    *(u32x2*)((u16*)(P.ws + WS_H) + (size_t)row * 2048 + col) = o;
}
__device__ __forceinline__ void out_small(const Params& P, int l, int tile, unsigned char* smem) {
    const int tid = opaque_tid();
    const int R0 = MP + (tile & 7) * 32, N0 = (tile >> 3) * 64;
    const u16* merged = (const u16*)(P.ws + WS_H);
    const u16* wtout = (const u16*)(P.ws + WS_WTOUT) + (size_t)l * 2048 * 2048;
    const int row = R0 + (tid >> 4), col = N0 + (tid & 15) * 4;
    const f32x4 s = small_pass<2048>(merged + (size_t)R0 * 2048, 2048, wtout + (size_t)N0 * 2048, smem);
    const float* src = l == 0 ? P.in[1] + (size_t)(row - MP) * D + col : P.out + (size_t)row * D + col;
    const f32x4 x = *(const f32x4*)src;
    *(f32x4*)(P.out + (size_t)row * D + col) = x + s;
}

template <int NMB>
__device__ __forceinline__ void rwkv_prep_tile(const Params& P, int l, int Rbase, unsigned char* smem) {
    const int tid = opaque_tid(), w = tid >> 6, lane = tid & 63, fr = lane & 15, fq = lane >> 4;
    u16* A1 = (u16*)smem; u16* A2 = A1 + 64 * 72;
    const u16* proj = (const u16*)(P.ws + WS_PROJ);
    const float* mu = P.in[11] + (size_t)l * SHIFT_W;
    __syncthreads();
    if (tid < NMB * 128) {
        const int tok = tid >> 3, seg = (tid & 7) * 16;
        const int R = Rbase + tok;
        bool first; const float* st = nullptr;
        if (R < MP) first = (R & 4095) == 0;
        else { const int rs = R - MP; first = (rs & 15) == 0; st = P.in[5] + (size_t)(l * 16 + (rs >> 4)) * SHIFT_W; }
        const u16* pc = proj + (size_t)R * NIN + OFF_SHIFT + 3072 + seg;
        float cur[16], prv[16];
        unpack8(*(const u32x4*)pc, cur); unpack8(*(const u32x4*)(pc + 8), cur + 8);
        if (!first) { unpack8(*(const u32x4*)(pc - NIN), prv); unpack8(*(const u32x4*)(pc - NIN + 8), prv + 8); }
        else {
#pragma unroll
            for (int e = 0; e < 16; ++e) prv[e] = st ? st[3072 + seg + e] : 0.f;
        }
        float xs[16];
#pragma unroll
        for (int e = 0; e < 16; ++e) { xs[e] = cur[e] + (prv[e] - cur[e]) * mu[3072 + seg + e]; if (seg < 64) xs[e] = tanhf(xs[e]); }
        u16* dstp = seg < 64 ? A1 + tok * 72 + seg : A2 + tok * 72 + (seg - 64);
        u32x4 w0, w1;
        w0.x = pk_bf16(xs[0], xs[1]); w0.y = pk_bf16(xs[2], xs[3]); w0.z = pk_bf16(xs[4], xs[5]); w0.w = pk_bf16(xs[6], xs[7]);
        w1.x = pk_bf16(xs[8], xs[9]); w1.y = pk_bf16(xs[10], xs[11]); w1.z = pk_bf16(xs[12], xs[13]); w1.w = pk_bf16(xs[14], xs[15]);
        *(u32x4*)dstp = w0; *(u32x4*)(dstp + 8) = w1;
    }
    __syncthreads();
    float* decay = (float*)(P.ws + WS_DEC); float* aa = (float*)(P.ws + WS_AA);
#pragma unroll 1
    for (int mat = 0; mat < 2; ++mat) {
        const u16* A = mat ? A2 : A1;
        const u16* Wt = (const u16*)(P.ws + (mat ? WS_AUPT : WS_WUPT)) + (size_t)l * 1024 * 64;
        const float* bias = (mat ? P.in[14] : P.in[12]) + (size_t)l * 1024;
        float* dstm = mat ? aa : decay;
        bf16x8 af[NMB][2];
#pragma unroll
        for (int mb = 0; mb < NMB; ++mb)
#pragma unroll
            for (int ks = 0; ks < 2; ++ks) af[mb][ks] = *(const bf16x8*)(A + (mb * 16 + fr) * 72 + ks * 32 + fq * 8);
#pragma unroll 2
        for (int nb = 0; nb < 8; ++nb) {
            const int n = w * 128 + nb * 16 + fr;
            bf16x8 bfr[2];
#pragma unroll
            for (int ks = 0; ks < 2; ++ks) bfr[ks] = *(const bf16x8*)(Wt + (size_t)n * 64 + ks * 32 + fq * 8);
            const int c = w * 128 + nb * 16 + fq * 4;
            const f32x4 bi = *(const f32x4*)(bias + c);
#pragma unroll
            for (int mb = 0; mb < NMB; ++mb) {
                f32x4 a = {0.f, 0.f, 0.f, 0.f};
#pragma unroll
                for (int ks = 0; ks < 2; ++ks) a = __builtin_amdgcn_mfma_f32_16x16x32_bf16(bfr[ks], af[mb][ks], a, 0, 0, 0);
                const int R = Rbase + mb * 16 + fr;
                f32x4 o;
#pragma unroll
                for (int j = 0; j < 4; ++j) { const float s = sigm(bi[j] + a[j]); o[j] = mat ? s : __expf(-0.60653066f * s); }
                *(f32x4*)(dstm + (size_t)R * 1024 + c) = o;
            }
        }
    }
}

typedef float f32x2 __attribute__((ext_vector_type(2)));
__device__ __forceinline__ void scan_item(const Params& P, int l, int v, unsigned char* smem, const int c0 = 0, int c1 = -1, const bool resume = false) {
    const int tid = opaque_tid(), w = tid >> 6, lane = tid & 63;
    float* sm = (float*)smem;
    float* bufs = sm;
    float* ybuf = sm + 2 * 16 * 384;
    const bool samp = v >= 64;
    int b, h, T; size_t row0;
    { const int chain = samp ? v - 64 : v; b = chain >> 4; h = chain & 15; }
    if (!samp) { T = 4096; row0 = (size_t)b * 4096; } else { T = 16; row0 = (size_t)MP + (size_t)b * 16; }
    const int nch = (c1 < 0 || c1 > (T >> 4)) ? (T >> 4) : c1;
    const u16* proj = (const u16*)(P.ws + WS_PROJ);
    __syncthreads();
    if (w < 4) {
        const int i0 = w * 16 + (lane >> 3), i1 = i0 + 8, js = (lane & 7) * 8;
        f32x2 S0, S1, S2, S3, T0, T1, T2, T3;
        if (samp) {
            const float* s0 = P.in[4] + ((size_t)(l * 16 + b) * 16 + h) * 4096 + js;
            const f32x4 a0 = *(const f32x4*)(s0 + i0 * 64), a1 = *(const f32x4*)(s0 + i0 * 64 + 4), c0 = *(const f32x4*)(s0 + i1 * 64), c1 = *(const f32x4*)(s0 + i1 * 64 + 4);
            S0 = a0.xy; S1 = a0.zw; S2 = a1.xy; S3 = a1.zw; T0 = c0.xy; T1 = c0.zw; T2 = c1.xy; T3 = c1.zw;
        } else if (resume) {
            const float* s0 = P.out + O_RP + ((size_t)(l * 4 + b) * 16 + h) * 4096 + js;
            const f32x4 a0 = *(const f32x4*)(s0 + i0 * 64), a1 = *(const f32x4*)(s0 + i0 * 64 + 4), c0v = *(const f32x4*)(s0 + i1 * 64), c1v = *(const f32x4*)(s0 + i1 * 64 + 4);
            S0 = a0.xy; S1 = a0.zw; S2 = a1.xy; S3 = a1.zw; T0 = c0v.xy; T1 = c0v.zw; T2 = c1v.xy; T3 = c1v.zw;
        } else { S0 = (f32x2){0.f, 0.f}; S1 = S0; S2 = S0; S3 = S0; T0 = S0; T1 = S0; T2 = S0; T3 = S0; }
        __syncthreads();
        for (int c = c0; c < nch; ++c) {
            const float* bb = bufs + (c & 1) * (16 * 384) + js;
            const float* bv = bufs + (c & 1) * (16 * 384) + 320 + i0;
            float* yb = ybuf + (c & 1) * 8192 + w * 64 + lane;
            f32x4 w0, w1, a0, a1, b0, b1, k0, k1, r0, r1; float vi, vj;
            f32x4 W0, W1, A0, A1, B0, B1, K0, K1, R0, R1; float VI, VJ;
#define SCAN_LOAD(w0, w1, a0, a1, b0, b1, k0, k1, r0, r1, vi, vj, t) do { const float* vb = bb + (t) * 384; \
                w0 = *(const f32x4*)(vb); w1 = *(const f32x4*)(vb + 4); a0 = *(const f32x4*)(vb + 64); a1 = *(const f32x4*)(vb + 68); \
                b0 = *(const f32x4*)(vb + 128); b1 = *(const f32x4*)(vb + 132); k0 = *(const f32x4*)(vb + 192); k1 = *(const f32x4*)(vb + 196); \
                r0 = *(const f32x4*)(vb + 256); r1 = *(const f32x4*)(vb + 260); vi = bv[(t) * 384]; vj = bv[(t) * 384 + 8]; } while (0)
#define SCAN_ROW(S0, S1, S2, S3, w0, w1, a0, a1, b0, b1, k0, k1, r0, r1, vi, yslot) do { const f32x2 vi2 = {vi, vi}; \
                f32x2 p = S0 * a0.xy; p = S1 * a0.zw + p; f32x2 q = S2 * a1.xy; q = S3 * a1.zw + q; \
                const f32x2 sw0 = S0 * w0.xy + vi2 * k0.xy, sw1 = S1 * w0.zw + vi2 * k0.zw, sw2 = S2 * w1.xy + vi2 * k1.xy, sw3 = S3 * w1.zw + vi2 * k1.zw; \
                p = p + q; const float dot = red8(p.x + p.y); const f32x2 d2 = {dot, dot}; \
                S0 = d2 * b0.xy + sw0; S1 = d2 * b0.zw + sw1; S2 = d2 * b1.xy + sw2; S3 = d2 * b1.zw + sw3; \
                f32x2 yp = S0 * r0.xy; yp = S1 * r0.zw + yp; f32x2 yq = S2 * r1.xy; yq = S3 * r1.zw + yq; yp = yp + yq; \
                yb[yslot] = yp.x + yp.y; } while (0)
#define SCAN_STEP(w0, w1, a0, a1, b0, b1, k0, k1, r0, r1, vi, vj, t) do { \
                SCAN_ROW(S0, S1, S2, S3, w0, w1, a0, a1, b0, b1, k0, k1, r0, r1, vi, (t) * 512); \
                SCAN_ROW(T0, T1, T2, T3, w0, w1, a0, a1, b0, b1, k0, k1, r0, r1, vj, (t) * 512 + 256); } while (0)
            SCAN_LOAD(w0, w1, a0, a1, b0, b1, k0, k1, r0, r1, vi, vj, 0);
#pragma unroll
            for (int t = 0; t < 16; t += 2) {
                SCAN_LOAD(W0, W1, A0, A1, B0, B1, K0, K1, R0, R1, VI, VJ, t + 1);
                SCAN_STEP(w0, w1, a0, a1, b0, b1, k0, k1, r0, r1, vi, vj, t);
                if (t + 2 < 16) SCAN_LOAD(w0, w1, a0, a1, b0, b1, k0, k1, r0, r1, vi, vj, t + 2);
                SCAN_STEP(W0, W1, A0, A1, B0, B1, K0, K1, R0, R1, VI, VJ, t + 1);
            }
#undef SCAN_LOAD
#undef SCAN_ROW
#undef SCAN_STEP
            __syncthreads();
        }
        float* so = P.out + (samp ? O_RS + ((size_t)(l * 16 + b) * 16 + h) * 4096 : O_RP + ((size_t)(l * 4 + b) * 16 + h) * 4096) + js;
        f32x4 o0, o1; o0.xy = S0; o0.zw = S1; o1.xy = S2; o1.zw = S3;
        *(f32x4*)(so + i0 * 64) = o0; *(f32x4*)(so + i0 * 64 + 4) = o1;
        o0.xy = T0; o0.zw = T1; o1.xy = T2; o1.zw = T3;
        *(f32x4*)(so + i1 * 64) = o0; *(f32x4*)(so + i1 * 64 + 4) = o1;
    } else {
        const int pw = w - 4;
        const float* decay = (const float*)(P.ws + WS_DEC); const float* aa = (const float*)(P.ws + WS_AA);
        float* yraw = (float*)(P.ws + WS_YRAW);
        const int col = h * 64 + lane;
        const float mu_r = P.in[11][(size_t)l * SHIFT_W + col], mu_k = P.in[11][(size_t)l * SHIFT_W + 1024 + col], mu_v = P.in[11][(size_t)l * SHIFT_W + 2048 + col];
        const float c_kk = P.in[16][l * 1024 + col], c_ka = P.in[17][l * 1024 + col];
        const float* sh0 = samp ? P.in[5] + (size_t)(l * 16 + b) * SHIFT_W : nullptr;
        float pr[2][4], pk[2][4], pv[2][4], qr[2][4], qk[2][4], qv[2][4], pd[2][4], pa[2][4];
        auto prep_load = [&](int c, auto SET) {
            constexpr int s = decltype(SET)::value;
#pragma unroll
            for (int u = 0; u < 4; ++u) {
                const int t = c * 16 + pw + u * 4;
                const u16* p = proj + (row0 + t) * NIN + OFF_SHIFT + col;
                pr[s][u] = bf2f(p[0]); pk[s][u] = bf2f(p[1024]); pv[s][u] = bf2f(p[2048]);
                if (t > 0) { qr[s][u] = bf2f(p[-NIN]); qk[s][u] = bf2f(p[1024 - NIN]); qv[s][u] = bf2f(p[2048 - NIN]); }
                else if (sh0) { qr[s][u] = sh0[col]; qk[s][u] = sh0[1024 + col]; qv[s][u] = sh0[2048 + col]; }
                else { qr[s][u] = 0.f; qk[s][u] = 0.f; qv[s][u] = 0.f; }
                pd[s][u] = decay[(row0 + t) * 1024 + col]; pa[s][u] = aa[(row0 + t) * 1024 + col];
            }
        };
        auto prep_store = [&](int c, auto SET) {
            constexpr int s = decltype(SET)::value;
            float* bb = bufs + (c & 1) * (16 * 384);
#pragma unroll
            for (int u = 0; u < 4; ++u) {
                const int tl = pw + u * 4;
                const float xr = pr[s][u] + (qr[s][u] - pr[s][u]) * mu_r, xk = pk[s][u] + (qk[s][u] - pk[s][u]) * mu_k, xv = pv[s][u] + (qv[s][u] - pv[s][u]) * mu_v;
                const float kkr = xk * c_kk;
                const float n2 = wave_sum(kkr * kkr);
                const float kk = kkr / fmaxf(sqrtf(n2), 1e-12f);
                const float kp = xk * (1.f + (pa[s][u] - 1.f) * c_ka);
                float* o = bb + tl * 384 + lane;
                o[0] = pd[s][u]; o[64] = -kk; o[128] = kk * pa[s][u]; o[192] = kp; o[256] = xr; o[320] = xv;
            }
        };
        auto drain = [&](int c) {
            const float* yb = ybuf + (c & 1) * 8192;
            const int pt = tid - 256, t = pt >> 4, rq = pt & 15;
            const float* src = yb + t * 512 + ((rq & 3) >> 1) * 256 + (rq >> 2) * 64 + (rq & 1) * 32;
            f32x4 o;
#pragma unroll
            for (int e = 0; e < 4; ++e) {
                const f32x4 y0 = *(const f32x4*)(src + e * 8), y1 = *(const f32x4*)(src + e * 8 + 4);
                o[e] = ((y0[0] + y0[1]) + (y0[2] + y0[3])) + ((y1[0] + y1[1]) + (y1[2] + y1[3]));
            }
            *(f32x4*)(yraw + (row0 + c * 16 + t) * 1024 + h * 64 + rq * 4) = o;
        };
        using I0 = std::integral_constant<int, 0>; using I1 = std::integral_constant<int, 1>;
        prep_load(c0, I0{}); prep_store(c0, I0{});
        if (c0 + 1 < nch) prep_load(c0 + 1, I1{});
        if (c0 + 2 < nch) prep_load(c0 + 2, I0{});
        __syncthreads();
        for (int c = c0; c < nch; c += 2) {
            if (c + 1 < nch) prep_store(c + 1, I1{});
            if (c + 3 < nch) prep_load(c + 3, I1{});
            if (c > c0) drain(c - 1);
            __syncthreads();
            if (c + 1 < nch) {
                if (c + 2 < nch) prep_store(c + 2, I0{});
                if (c + 4 < nch) prep_load(c + 4, I0{});
                drain(c);
                __syncthreads();
            }
        }
        drain(nch - 1);
    }
}

__device__ __forceinline__ float red16(float x) { x += dppf<0xB1>(x); x += dppf<0x4E>(x); x += dppf<0x141>(x); x += dppf<0x140>(x); return x; }
__device__ __forceinline__ void rwkv_post_rows(const Params& P, int l, int rbeg, int rend) {
    const int tid = opaque_tid(), w = tid >> 6, lane = tid & 63;
    u16* proj = (u16*)(P.ws + WS_PROJ);
    const float* aa = (const float*)(P.ws + WS_AA); const float* yraw = (const float*)(P.ws + WS_YRAW);
    const float* mu = P.in[11] + (size_t)l * SHIFT_W;
#pragma unroll 1
    for (int R = rbeg + w; R < rend; R += 8) {
        bool first; const float* st = nullptr;
        if (R < MP) first = (R & 4095) == 0;
        else { const int rs = R - MP; first = (rs & 15) == 0; st = P.in[5] + (size_t)(l * 16 + (rs >> 4)) * SHIFT_W; }
#pragma unroll
        for (int hq = 0; hq < 4; ++hq) {
            const int col = hq * 256 + lane * 4;
            const u16* p = proj + (size_t)R * NIN + OFF_SHIFT + col;
            const u32x2 cr = *(const u32x2*)p, ck = *(const u32x2*)(p + 1024), cv = *(const u32x2*)(p + 2048);
            float pr[4] = {lo_bf(cr.x), hi_bf(cr.x), lo_bf(cr.y), hi_bf(cr.y)}, pk[4] = {lo_bf(ck.x), hi_bf(ck.x), lo_bf(ck.y), hi_bf(ck.y)},
                  pv[4] = {lo_bf(cv.x), hi_bf(cv.x), lo_bf(cv.y), hi_bf(cv.y)};
            float qr[4], qk[4], qv[4];
            if (!first) {
                const u32x2 dr = *(const u32x2*)(p - NIN), dk = *(const u32x2*)(p + 1024 - NIN), dv = *(const u32x2*)(p + 2048 - NIN);
                qr[0] = lo_bf(dr.x); qr[1] = hi_bf(dr.x); qr[2] = lo_bf(dr.y); qr[3] = hi_bf(dr.y);
                qk[0] = lo_bf(dk.x); qk[1] = hi_bf(dk.x); qk[2] = lo_bf(dk.y); qk[3] = hi_bf(dk.y);
                qv[0] = lo_bf(dv.x); qv[1] = hi_bf(dv.x); qv[2] = lo_bf(dv.y); qv[3] = hi_bf(dv.y);
            } else {
#pragma unroll
                for (int e = 0; e < 4; ++e) { qr[e] = st ? st[col + e] : 0.f; qk[e] = st ? st[1024 + col + e] : 0.f; qv[e] = st ? st[2048 + col + e] : 0.f; }
            }
            const f32x4 mr = *(const f32x4*)(mu + col), mk = *(const f32x4*)(mu + 1024 + col), mv = *(const f32x4*)(mu + 2048 + col);
            const f32x4 a = *(const f32x4*)(aa + (size_t)R * 1024 + col);
            const f32x4 ka = *(const f32x4*)(P.in[17] + l * 1024 + col), rk = *(const f32x4*)(P.in[18] + l * 1024 + col);
            const f32x4 gw = *(const f32x4*)(P.in[19] + l * 1024 + col), gb = *(const f32x4*)(P.in[20] + l * 1024 + col);
            const f32x4 y = *(const f32x4*)(yraw + (size_t)R * 1024 + col);
            float xv[4], bon = 0.f;
#pragma unroll
            for (int e = 0; e < 4; ++e) {
                const float xr = pr[e] + (qr[e] - pr[e]) * mr[e], xk = pk[e] + (qk[e] - pk[e]) * mk[e];
                xv[e] = pv[e] + (qv[e] - pv[e]) * mv[e];
                bon += xr * (xk * (1.f + (a[e] - 1.f) * ka[e])) * rk[e];
            }
            bon = red16(bon);
            const float mean = red16(y[0] + y[1] + y[2] + y[3]) * (1.f / 64.f);
            float d[4], vs = 0.f;
#pragma unroll
            for (int e = 0; e < 4; ++e) { d[e] = y[e] - mean; vs += d[e] * d[e]; }
            const float rstd = rsqrtf(red16(vs) * (1.f / 64.f) + 64e-5f);
            u16* gp = proj + (size_t)R * NIN + OFF_GATE + 1024 + col;
            const u32x2 gz = *(const u32x2*)gp;
            float o[4];
#pragma unroll
            for (int e = 0; e < 4; ++e) o[e] = d[e] * rstd * gw[e] + gb[e] + bon * xv[e];
            u32x2 ow; ow.x = pk_bf16(o[0] * lo_bf(gz.x), o[1] * hi_bf(gz.x)); ow.y = pk_bf16(o[2] * lo_bf(gz.y), o[3] * hi_bf(gz.y));
            *(u32x2*)gp = ow;
        }
    }
}

__device__ __forceinline__ void pool_item(const Params& P, int l, int item, unsigned char* smem, const bool dry = false) {
    const int tid = opaque_tid(), w = tid >> 6, lane = tid & 63, fr = lane & 15, fq = lane >> 4;
    const int tile = item >> 2, g = item & 3;
    u16* At = (u16*)smem;
    u16* proj = (u16*)(P.ws + WS_PROJ);
    __syncthreads();
    {
        const int cp = tid & 127, tq = tid >> 7;
        const int c = g * 256 + cp * 2;
        auto build = [&](auto WINC) {
            constexpr int WIN = decltype(WINC)::value;
#pragma unroll 1
            for (int sub = 0; sub < 2; ++sub) {
                const int unit = tq * 2 + sub;
                const int R0 = tile * 128 + unit * 16;
                const bool samp = R0 >= MP;
                int t0; const float* hist = nullptr;
                if (!samp) t0 = R0 & 4095; else { t0 = 0; hist = P.in[6] + (size_t)(l * 16 + ((R0 - MP) >> 4)) * 15 * 1024; }
                float u0[WIN - 1 + 16], u1[WIN - 1 + 16];
#pragma unroll
                for (int k = 0; k < WIN - 1 + 16; ++k) {
                    const int dt = k - (WIN - 1), t = t0 + dt;
                    if (t >= 0) { const unsigned wv = *(const unsigned*)(proj + (size_t)(R0 + dt) * NIN + c); u0[k] = lo_bf(wv); u1[k] = hi_bf(wv); }
                    else if (hist) { const float* hp = hist + (size_t)(15 + t) * 1024 + c; u0[k] = hp[0]; u1[k] = hp[1]; }
                    else { u0[k] = 0.f; u1[k] = 0.f; }
                }
                float s0 = 0.f, s1 = 0.f;
#pragma unroll
                for (int k = 0; k < WIN - 1; ++k) { s0 += u0[k]; s1 += u1[k]; }
#pragma unroll
                for (int tt = 0; tt < 16; ++tt) {
                    s0 += u0[WIN - 1 + tt]; s1 += u1[WIN - 1 + tt];
                    const int pos = t0 + tt;
                    const float cnt = samp ? (float)WIN : (float)((pos + 1) < WIN ? (pos + 1) : WIN);
                    const float inv = 1.f / cnt;
                    *(unsigned*)(At + (unit * 16 + tt) * 264 + cp * 2) = pk_bf16(s0 * inv - u0[WIN - 1 + tt], s1 * inv - u1[WIN - 1 + tt]);
                    s0 -= u0[tt]; s1 -= u1[tt];
                }
            }
        };
        if (g == 0) build(std::integral_constant<int, 2>{});
        else if (g == 1) build(std::integral_constant<int, 4>{});
        else if (g == 2) build(std::integral_constant<int, 8>{});
        else build(std::integral_constant<int, 16>{});
    }
    __syncthreads();
    const u16* Wt = (const u16*)(P.ws + WS_WTPOOL) + (size_t)(l * 4 + g) * 65536;
    const int mrow0 = (w & 1) * 64, ncol0 = (w >> 1) * 64;
    f32x4 acc[4][4];
#pragma unroll
    for (int a = 0; a < 4; ++a)
#pragma unroll
        for (int b = 0; b < 4; ++b) acc[a][b] = (f32x4){0.f, 0.f, 0.f, 0.f};
#pragma unroll 2
    for (int ks = 0; ks < 8; ++ks) {
        bf16x8 af[4], bfr[4];
#pragma unroll
        for (int mb = 0; mb < 4; ++mb) af[mb] = *(const bf16x8*)(At + (mrow0 + mb * 16 + fr) * 264 + ks * 32 + fq * 8);
#pragma unroll
        for (int nb = 0; nb < 4; ++nb) bfr[nb] = *(const bf16x8*)(Wt + (size_t)(ncol0 + nb * 16 + fr) * 256 + ks * 32 + fq * 8);
#pragma unroll
        for (int nb = 0; nb < 4; ++nb)
#pragma unroll
            for (int mb = 0; mb < 4; ++mb) acc[nb][mb] = __builtin_amdgcn_mfma_f32_16x16x32_bf16(bfr[nb], af[mb], acc[nb][mb], 0, 0, 0);
    }
    const float* psc = P.in[10] + (size_t)l * 1024;
#pragma unroll
    for (int nb = 0; nb < 4; ++nb) {
        const int colg = g * 256 + ncol0 + nb * 16 + fq * 4;
        const f32x4 sc = *(const f32x4*)(psc + colg);
#pragma unroll
        for (int mb = 0; mb < 4; ++mb) {
            const int R = tile * 128 + mrow0 + mb * 16 + fr;
            u16* gp = proj + (size_t)R * NIN + OFF_GATE + colg;
            const u32x2 gz = *(const u32x2*)gp;
            u32x2 o;
            o.x = pk_bf16(acc[nb][mb][0] * sc[0] * lo_bf(gz.x), acc[nb][mb][1] * sc[1] * hi_bf(gz.x));
            o.y = pk_bf16(acc[nb][mb][2] * sc[2] * lo_bf(gz.y), acc[nb][mb][3] * sc[3] * hi_bf(gz.y));
            if (!dry) *(u32x2*)gp = o;
        }
    }
}

__device__ __forceinline__ int t5_bucket_n(int n) {
    const int ret = n < 0 ? 16 : 0;
    n = n < 0 ? -n : n;
    int v;
    if (n < 8) v = n; else if (n < 12) v = 8; else if (n < 16) v = 9; else if (n < 23) v = 10; else if (n < 32) v = 11;
    else if (n < 46) v = 12; else if (n < 64) v = 13; else if (n < 91) v = 14; else v = 15;
    return ret + v;
}
__device__ __forceinline__ void attn_item(const Params& P, int l, int item, unsigned char* smem, const bool dry = false) {
    const int tid = opaque_tid(), w = tid >> 6, lane = tid & 63, lq = lane & 31, hh = lane >> 5;
    u16* Ks = (u16*)smem;
    u16* Vt = Ks + 192 * 72;
    float* biasT = (float*)(Vt + 64 * 200);
    u16* proj = (u16*)(P.ws + WS_PROJ);
    const bool samp = item >= 1024;
    int b, nc = 0, kh;
    if (!samp) { b = item >> 8; nc = (item >> 2) & 63; kh = item & 3; } else { const int it = item - 1024; b = it >> 2; kh = it & 3; }
    const size_t qrow0 = samp ? (size_t)MP + (size_t)b * 16 : (size_t)b * 4096 + (size_t)nc * 64;
    __syncthreads();
    for (int idx = tid; idx < 1536; idx += 512) {
        const int s = idx >> 3, d0 = (idx & 7) * 8;
        float kf[8], vf[8];
        bool valid = true, fromproj = true; size_t row = 0;
        if (!samp) { const int tk = nc * 64 - 128 + s; if (tk < 0) valid = false; else row = (size_t)b * 4096 + tk; }
        else { if (s < 128) fromproj = false; else if (s < 144) row = (size_t)MP + (size_t)b * 16 + (s - 128); else valid = false; }
        if (!valid) {
#pragma unroll
            for (int e = 0; e < 8; ++e) { kf[e] = 0.f; vf[e] = 0.f; }
        } else if (fromproj) {
            unpack8(*(const u32x4*)(proj + row * NIN + OFF_K + kh * 64 + d0), kf);
            unpack8(*(const u32x4*)(proj + row * NIN + OFF_V + kh * 64 + d0), vf);
        } else {
            const size_t o = (((size_t)(l * 16 + b) * 128 + s) * 4 + kh) * 64 + d0;
            const f32x4 k0 = *(const f32x4*)(P.in[2] + o), k1 = *(const f32x4*)(P.in[2] + o + 4);
            const f32x4 v0 = *(const f32x4*)(P.in[3] + o), v1 = *(const f32x4*)(P.in[3] + o + 4);
#pragma unroll
            for (int e = 0; e < 4; ++e) { kf[e] = k0[e]; kf[4 + e] = k1[e]; vf[e] = v0[e]; vf[4 + e] = v1[e]; }
        }
        u32x4 kw; kw.x = pk_bf16(kf[0], kf[1]); kw.y = pk_bf16(kf[2], kf[3]); kw.z = pk_bf16(kf[4], kf[5]); kw.w = pk_bf16(kf[6], kf[7]);
        *(u32x4*)(Ks + s * 72 + d0) = kw;
#pragma unroll
        for (int e = 0; e < 8; ++e) Vt[(d0 + e) * 200 + s] = f2bf(vf[e]);
    }
    for (int idx = tid; idx < 1024; idx += 512) {
        const int g = idx >> 8, x = idx & 255;
        biasT[idx] = P.in[22][t5_bucket_n(x - 63) * 16 + kh * 4 + g];
    }
    __syncthreads();
    const int nrows = samp ? 64 : 256;
    if (w * 32 < nrows) {
        const int r = w * 32 + lq;
        int g, t;
        if (!samp) { g = r >> 6; t = r & 63; } else { g = r >> 4; t = r & 15; }
        const int head = kh * 4 + g;
        const size_t qrow = qrow0 + t;
        bf16x8 qf[4];
#pragma unroll
        for (int ks = 0; ks < 4; ++ks) qf[ks] = *(const bf16x8*)(proj + qrow * NIN + OFF_Q + head * 64 + ks * 16 + hh * 8);
        const int kb_lo = samp ? 0 : (nc >= 2 ? 0 : (2 - nc) * 2);
        const int kb_hi = samp ? 5 : 6;
        f32x16 sc[6];
#pragma unroll
        for (int kb = 0; kb < 6; ++kb) {
#pragma unroll
            for (int j = 0; j < 16; ++j) sc[kb][j] = 0.f;
            if (kb >= kb_lo && kb < kb_hi) {
#pragma unroll
                for (int ks = 0; ks < 4; ++ks) {
                    const bf16x8 kf = *(const bf16x8*)(Ks + (kb * 32 + lq) * 72 + ks * 16 + hh * 8);
                    sc[kb] = __builtin_amdgcn_mfma_f32_32x32x16_bf16(kf, qf[ks], sc[kb], 0, 0, 0);
                }
            }
        }
        const float sink = P.in[21][l * 16 + head];
        const float* bt = biasT + g * 256 + 63 + t + 128;
        float mx = sink;
#pragma unroll
        for (int kb = 0; kb < 6; ++kb) {
            if (kb >= kb_lo && kb < kb_hi) {
#pragma unroll
                for (int j = 0; j < 16; ++j) {
                    const int key = kb * 32 + 8 * (j >> 2) + 4 * hh + (j & 3);
                    float lg = sc[kb][j] * 0.125f + bt[-key];
                    if (samp && key >= 144) lg = -1e30f;
                    sc[kb][j] = lg; mx = fmaxf(mx, lg);
                }
            }
        }
        mx = fmaxf(mx, __shfl_xor(mx, 32));
        float sum = 0.f;
#pragma unroll
        for (int kb = 0; kb < 6; ++kb) {
            if (kb >= kb_lo && kb < kb_hi) {
#pragma unroll
                for (int j = 0; j < 16; ++j) { const float p = __expf(sc[kb][j] - mx); sc[kb][j] = p; sum += p; }
            }
        }
        sum += __shfl_xor(sum, 32);
        sum += __expf(sink - mx);
        const float inv = 1.f / sum;
        f32x16 oacc[2];
#pragma unroll
        for (int db = 0; db < 2; ++db)
#pragma unroll
            for (int j = 0; j < 16; ++j) oacc[db][j] = 0.f;
#pragma unroll
        for (int kb = 0; kb < 6; ++kb) {
            if (kb >= kb_lo && kb < kb_hi) {
#pragma unroll
                for (int k2 = 0; k2 < 2; ++k2) {
                    u32x4 pw;
                    pw.x = pk_bf16(sc[kb][8 * k2 + 0], sc[kb][8 * k2 + 1]); pw.y = pk_bf16(sc[kb][8 * k2 + 2], sc[kb][8 * k2 + 3]);
                    pw.z = pk_bf16(sc[kb][8 * k2 + 4], sc[kb][8 * k2 + 5]); pw.w = pk_bf16(sc[kb][8 * k2 + 6], sc[kb][8 * k2 + 7]);
                    bf16x8 pf; __builtin_memcpy(&pf, &pw, 16);
#pragma unroll
                    for (int db = 0; db < 2; ++db) {
                        const u16* vp = Vt + (db * 32 + lq) * 200 + kb * 32 + 16 * k2 + 4 * hh;
                        u32x4 vw; const u32x2 va = *(const u32x2*)vp, vb2 = *(const u32x2*)(vp + 8);
                        vw.x = va.x; vw.y = va.y; vw.z = vb2.x; vw.w = vb2.y;
                        bf16x8 vfr; __builtin_memcpy(&vfr, &vw, 16);
                        oacc[db] = __builtin_amdgcn_mfma_f32_32x32x16_bf16(vfr, pf, oacc[db], 0, 0, 0);
                    }
                }
            }
        }
#pragma unroll
        for (int db = 0; db < 2; ++db)
#pragma unroll
            for (int jq = 0; jq < 4; ++jq) {
                const int d = db * 32 + 8 * jq + 4 * hh;
                u16* gp = proj + qrow * NIN + OFF_GATE + 2048 + head * 64 + d;
                const u32x2 gz = *(const u32x2*)gp;
                u32x2 o;
                o.x = pk_bf16(oacc[db][4 * jq + 0] * inv * lo_bf(gz.x), oacc[db][4 * jq + 1] * inv * hi_bf(gz.x));
                o.y = pk_bf16(oacc[db][4 * jq + 2] * inv * lo_bf(gz.y), oacc[db][4 * jq + 3] * inv * hi_bf(gz.y));
                if (!dry) *(u32x2*)gp = o;
            }
    }
}

template <int l>
__device__ __forceinline__ void layer_body(const Params& P, cg::grid_group& grid, unsigned char* smem) {
    const int G = gridDim.x, bid = blockIdx.x;
    unsigned* ctl = (unsigned*)(P.ws + WS_CTL);
    u16* wtin = (u16*)(P.ws + WS_WTIN); u16* wtbr = (u16*)(P.ws + WS_WTBR); u16* wtout = (u16*)(P.ws + WS_WTOUT);
    u16* hbuf = (u16*)(P.ws + WS_H); u16* proj = (u16*)(P.ws + WS_PROJ);
    float* accf = (float*)(P.ws + WS_DEC);
    LAS unsigned char* lds = (LAS unsigned char*)smem;
    LAS int* slot = (LAS int*)(lds + 131072);
    (void)accf;
        const u16* wt_l = wtin + (size_t)l * NIN_PAD * 2048;
        EpiIn ein{proj};
#if PROBE == 17
        { EpiIn edry{proj, true}; SchedIn S{hbuf, wt_l, 0, nullptr, slot, G, bid, 0, opaque_tid() == 0}; gemm_phase(lds, 2048, 2048, S, edry); }
        grid.sync();
#endif
#if PROBE == 2
        { SchedIn S{hbuf, wt_l, 0, nullptr, slot, G, bid, 0, opaque_tid() == 0}; gemm_phase(lds, 2048, 2048, S, ein); }
        grid.sync();
#endif
#if PH_MASK & 4
        { SchedIn S{hbuf, wt_l, 0, nullptr, slot, G, bid, 0, opaque_tid() == 0}; gemm_phase(lds, 2048, 2048, S, ein); }
#endif
        grid.sync();
#if PROBE == 3
        for (int t = bid; t < MP / 64; t += G) rwkv_prep_tile<4>(P, l, t * 64, smem);
        for (int t = bid; t < MS / 16; t += G) rwkv_prep_tile<1>(P, l, MP + t * 16, smem);
        grid.sync();
#endif
        for (int t = bid; t < MP / 64; t += G) rwkv_prep_tile<4>(P, l, t * 64, smem);
        for (int t = bid; t < MS / 16; t += G) rwkv_prep_tile<1>(P, l, MP + t * 16, smem);
        grid.sync();
#if PROBE == 10
        for (int v = bid; v < 320; v += G) scan_item(P, l, v, smem);
        __syncthreads();
        { SchedIn S{hbuf, wt_l, 1, ctl + 32 + l * 16, slot, G, bid, 0, opaque_tid() == 0}; gemm_phase(lds, 2048, 2048, S, ein); }
        grid.sync();
#endif
#if PROBE == 12
        { SchedIn S{hbuf, wt_l, 1, ctl + 32 + l * 16, slot, G, bid, 0, opaque_tid() == 0}; gemm_phase(lds, 2048, 2048, S, ein); }
        grid.sync();
#endif
#if PROBE == 11
        for (int v = bid; v < 320; v += G) scan_item(P, l, v, smem);
        grid.sync();
#endif
        if (G > 128) {
            if (bid < 64) scan_item(P, l, bid, smem, 0, 192);
            else { SchedIn S{hbuf, wt_l, 1, nullptr, slot, G - 64, bid - 64, 0, false}; gemm_phase(lds, 2048, 2048, S, ein); }
            grid.sync();
            if (bid < 64) scan_item(P, l, bid, smem, 192, 256, true);
            else {
                for (int v = bid; v < 320; v += G - 64) scan_item(P, l, v, smem);
                side_outputs(P, l, G - 64, bid - 64);
                for (int it = bid - 64; it < 1088 + 520; it += G - 64) { if (it < 1088) attn_item(P, l, it, smem); else pool_item(P, l, it - 1088, smem); }
            }
            grid.sync();
            { const int per = (M + G - 1) / G, rb = bid * per; rwkv_post_rows(P, l, rb, (rb + per) < M ? (rb + per) : M); }
        } else {
            for (int v = bid; v < 320; v += G) scan_item(P, l, v, smem);
            __syncthreads();
            { SchedIn S{hbuf, wt_l, 1, ctl + l * 16, slot, G, bid, 0, opaque_tid() == 0}; gemm_phase(lds, 2048, 2048, S, ein); }
            grid.sync();
            side_outputs(P, l, G, bid);
            for (int it = bid; it < 1088 + 520 + 520; it += G) {
                if (it < 1088) attn_item(P, l, it, smem);
                else if (it < 1608) pool_item(P, l, it - 1088, smem);
                else rwkv_post_rows(P, l, (it - 1608) * 32, (it - 1608) * 32 + 32);
            }
        }
        grid.sync();
#if PROBE == 16
        { SchedBrDense S{hbuf, wtbr + (size_t)l * 3 * 2048 * 1024, G, bid}; EpiBr e{proj, (u16*)accf}; __syncthreads(); gemm_phase(lds, 1024, 2048, S, e); }
        grid.sync();
#endif
#if PROBE == 13
        { SchedBr S{proj, wtbr + (size_t)l * 3 * 2048 * 1024, G, bid}; EpiBr e{proj, hbuf}; __syncthreads(); gemm_phase(lds, 1024, NIN, S, e); }
        grid.sync();
#endif
#if PROBE == 14
        for (int t = bid; t < 256; t += G) branch_small(P, l, t, smem);
        grid.sync();
#endif
#if PROBE == 15
        grid.sync();
#endif
#if PROBE == 8
        { SchedBr S{proj, wtbr + (size_t)l * 3 * 2048 * 1024, G, bid}; EpiBr e{proj, hbuf}; __syncthreads(); gemm_phase(lds, 1024, NIN, S, e); }
        for (int t = bid; t < 256; t += G) branch_small(P, l, t, smem);
        grid.sync();
#endif
#if PH_MASK & 256
        { SchedBr S{proj, wtbr + (size_t)l * 3 * 2048 * 1024, G, bid}; EpiBr e{proj, hbuf}; __syncthreads(); gemm_phase(lds, 1024, NIN, S, e); }
        for (int t = bid; t < 256; t += G) branch_small(P, l, t, smem);
#endif
        grid.sync();
#if PROBE == 9
        { SchedOut S{hbuf, wtout + (size_t)l * 2048 * 2048, G, bid};
          EpiOut e{l == 0 ? P.in[0] : P.out, l == 0 ? P.in[1] : P.out + (size_t)MP * D, accf}; gemm_phase(lds, 2048, 2048, S, e); }
        grid.sync();
#endif
#if PH_MASK & 512
        { SchedOut S{hbuf, wtout + (size_t)l * 2048 * 2048, G, bid};
          EpiOut e{l == 0 ? P.in[0] : P.out, l == 0 ? P.in[1] : P.out + (size_t)MP * D, P.out}; gemm_phase(lds, 2048, 2048, S, e); }
        for (int t = bid; t < 256; t += G) out_small(P, l, t, smem);
#endif
        grid.sync();
        if (l == 0) { rms_rows<true>(P.out, P.out + (size_t)MP * D, P.in[7] + D, hbuf, nullptr); grid.sync(); }
    }

__global__ void __launch_bounds__(512, 2) fwd_megakernel(Params P) {
    extern __shared__ __attribute__((aligned(16))) unsigned char smem[];
    cg::grid_group grid = cg::this_grid();
    const int G = gridDim.x, bid = blockIdx.x;
    unsigned* ctl = (unsigned*)(P.ws + WS_CTL);
    u16* wtin = (u16*)(P.ws + WS_WTIN); u16* wtbr = (u16*)(P.ws + WS_WTBR); u16* wtout = (u16*)(P.ws + WS_WTOUT);
    u16* wtpool = (u16*)(P.ws + WS_WTPOOL); u16* wupt = (u16*)(P.ws + WS_WUPT); u16* aupt = (u16*)(P.ws + WS_AUPT);
    u16* hbuf = (u16*)(P.ws + WS_H); u16* proj = (u16*)(P.ws + WS_PROJ);
    float* accf = (float*)(P.ws + WS_DEC);
    LAS unsigned char* lds = (LAS unsigned char*)smem;
    LAS int* slot = (LAS int*)(lds + 131072);

    if ((threadIdx.x & 63) == 0) ((volatile int*)(smem + 131072 + 256))[__builtin_amdgcn_s_getreg(10244) & 63] = threadIdx.x >> 6;
    __syncthreads();
    if (bid == 0 && opaque_tid() < 64) ctl[opaque_tid()] = 0u;
#if PH_MASK & 1
    for (int rep = 0; rep < (PROBE == 1 ? 2 : 1); ++rep) {
        int base = 0; float* tile = (float*)smem;
        for (int l = 0; l < 2; ++l) {
            tr_cvt(P.in[8] + (size_t)l * 2048 * NIN, 2048, NIN, wtin + (size_t)l * NIN_PAD * 2048, base, tile);
            for (int b = 0; b < 3; ++b) tr_cvt(P.in[23] + (size_t)(l * 3 + b) * 1024 * 2048, 1024, 2048, wtbr + (size_t)(l * 3 + b) * 2048 * 1024, base, tile);
            tr_cvt(P.in[24] + (size_t)l * 2048 * 2048, 2048, 2048, wtout + (size_t)l * 2048 * 2048, base, tile);
            for (int g = 0; g < 4; ++g) tr_cvt(P.in[9] + (size_t)(l * 4 + g) * 65536, 256, 256, wtpool + (size_t)(l * 4 + g) * 65536, base, tile);
            tr_cvt(P.in[13] + (size_t)l * 64 * 1024, 64, 1024, wupt + (size_t)l * 1024 * 64, base, tile);
            tr_cvt(P.in[15] + (size_t)l * 64 * 1024, 64, 1024, aupt + (size_t)l * 1024 * 64, base, tile);
        }
    }
#endif
#if PH_MASK & 2
    rms_rows<true>(P.in[0], P.in[1], P.in[7], hbuf, nullptr);
#endif
    grid.sync();

    layer_body<0>(P, grid, smem);
    layer_body<1>(P, grid, smem);
    rms_rows<false>(P.out, P.out + (size_t)MP * D, P.in[25], nullptr, P.out);
}

extern "C" void kernel_launch(void* const* d_in, const int* in_sizes, int n_in, void* d_out, int out_size, void* d_ws, size_t ws_size, hipStream_t stream) {
    static int grid_blocks = 0;
    if (grid_blocks == 0) {
        if (n_in != 26 || (size_t)out_size != O_END || ws_size < WS_END) {
            fprintf(stderr, "kernel_launch: unexpected shapes: n_in %d out %d ws %zu (need %zu)\n", n_in, out_size, ws_size, (size_t)WS_END); grid_blocks = -1; return; }
        int dev = 0, cus = 0, per_cu = 0;
        hipGetDevice(&dev);
        hipDeviceGetAttribute(&cus, hipDeviceAttributeMultiprocessorCount, dev);
        hipFuncSetAttribute((const void*)fwd_megakernel, hipFuncAttributeMaxDynamicSharedMemorySize, LDS_BYTES);
        hipOccupancyMaxActiveBlocksPerMultiprocessor(&per_cu, (const void*)fwd_megakernel, 512, LDS_BYTES);
        if (per_cu < 1) per_cu = 1;
        grid_blocks = cus * per_cu;
        if (grid_blocks > 256) grid_blocks = 256;
    }
    if (grid_blocks < 0) return;
    Params p{};
    for (int i = 0; i < 26; ++i) p.in[i] = (const float*)d_in[i];
    p.out = (float*)d_out; p.ws = (unsigned char*)d_ws;
    void* args[] = {&p};
    hipError_t e = hipLaunchCooperativeKernel((const void*)fwd_megakernel, dim3(grid_blocks), dim3(512), args, LDS_BYTES, stream);
    if (e != hipSuccess) fprintf(stderr, "cooperative launch failed: %s (grid %d)\n", hipGetErrorString(e), grid_blocks);
}
```

```cpp
#include <hip/hip_runtime.h>
#include <hip/hip_cooperative_groups.h>
#include <cstdio>
#include <type_traits>
namespace cg = cooperative_groups;

#define LAS __attribute__((address_space(3)))
typedef unsigned short u16;
typedef short bf16x8 __attribute__((ext_vector_type(8)));
typedef float f32x4 __attribute__((ext_vector_type(4)));
typedef float f32x16 __attribute__((ext_vector_type(16)));
typedef unsigned u32x4 __attribute__((ext_vector_type(4)));
typedef unsigned u32x2 __attribute__((ext_vector_type(2)));

constexpr int D = 2048, MP = 16384, MS = 256, M = MP + MS;
constexpr int NIN = 14976, NIN_PAD = 15104;
constexpr int OFF_POOL = 0, OFF_SHIFT = 1024, OFF_Q = 4224, OFF_K = 5248, OFF_V = 5504, OFF_GATE = 5760, OFF_MERGE = 8832;
constexpr int SHIFT_W = 3200;
constexpr size_t O_YP = 0, O_YS = O_YP + (size_t)MP * D, O_KP = O_YS + (size_t)MS * D, O_VP = O_KP + 2 * 4 * 128 * 256, O_KS = O_VP + 2 * 4 * 128 * 256,
                 O_VS = O_KS + 2 * 16 * 16 * 256, O_RP = O_VS + 2 * 16 * 16 * 256, O_RS = O_RP + 2 * 4 * 16 * 4096, O_SHP = O_RS + 2 * 16 * 16 * 4096,
                 O_SHS = O_SHP + 2 * 4 * 3200, O_PLP = O_SHS + 2 * 16 * 3200, O_PLS = O_PLP + 2 * 4 * 15 * 1024, O_END = O_PLS + 2 * 16 * 15 * 1024;
constexpr size_t WS_CTL = 0, WS_WTIN = 4096, WS_WTBR = WS_WTIN + (size_t)2 * NIN_PAD * 2048 * 2, WS_WTOUT = WS_WTBR + (size_t)2 * 3 * 2048 * 1024 * 2,
                 WS_WTPOOL = WS_WTOUT + (size_t)2 * 2048 * 2048 * 2, WS_WUPT = WS_WTPOOL + (size_t)2 * 4 * 256 * 256 * 2, WS_AUPT = WS_WUPT + (size_t)2 * 1024 * 64 * 2,
                 WS_H = WS_AUPT + (size_t)2 * 1024 * 64 * 2, WS_PROJ = WS_H + (size_t)M * 2048 * 2, WS_DEC = WS_PROJ + (size_t)M * NIN * 2,
                 WS_AA = WS_DEC + (size_t)M * 1024 * 4, WS_YRAW = WS_AA + (size_t)M * 1024 * 4, WS_END = WS_YRAW + (size_t)M * 1024 * 4;
constexpr int LDS_BYTES = 131072 + 512;

struct Params { const float* in[26]; float* out; unsigned char* ws; };

__device__ __forceinline__ unsigned pk_bf16(float lo, float hi) { unsigned r; asm("v_cvt_pk_bf16_f32 %0, %1, %2" : "=v"(r) : "v"(lo), "v"(hi)); return r; }
__device__ __forceinline__ u16 f2bf(float x) { return (u16)(pk_bf16(x, 0.f) & 0xffffu); }
__device__ __forceinline__ float bf2f(u16 x) { return __uint_as_float(((unsigned)x) << 16); }
__device__ __forceinline__ float lo_bf(unsigned w) { return __uint_as_float(w << 16); }
__device__ __forceinline__ float hi_bf(unsigned w) { return __uint_as_float(w & 0xffff0000u); }
__device__ __forceinline__ float sigm(float x) { return __builtin_amdgcn_rcpf(1.f + __expf(-x)); }
__device__ __forceinline__ int opaque_tid() {
    extern __shared__ __attribute__((aligned(16))) unsigned char smem_all[];
    const int key = __builtin_amdgcn_s_getreg(10244) & 63;
    int wv = ((const volatile int*)(smem_all + 131072 + 256))[key];
    wv = __builtin_amdgcn_readfirstlane(wv);
    int t = (wv << 6) | (int)__builtin_amdgcn_mbcnt_hi(~0u, __builtin_amdgcn_mbcnt_lo(~0u, 0u));
    asm volatile("" : "+v"(t)); return t; }
template <int CTRL> __device__ __forceinline__ float dppf(float x) { return __int_as_float(__builtin_amdgcn_update_dpp(0, __float_as_int(x), CTRL, 0xF, 0xF, true)); }
__device__ __forceinline__ float wave_sum(float x) {
    x += dppf<0xB1>(x); x += dppf<0x4E>(x); x += dppf<0x141>(x); x += dppf<0x140>(x);
    x += __int_as_float(__builtin_amdgcn_update_dpp(0, __float_as_int(x), 0x142, 0xA, 0xF, false));
    x += __int_as_float(__builtin_amdgcn_update_dpp(0, __float_as_int(x), 0x143, 0xC, 0xF, false));
    return __int_as_float(__builtin_amdgcn_readlane(__float_as_int(x), 63));
}
__device__ __forceinline__ float red8(float x) { x += dppf<0xB1>(x); x += dppf<0x4E>(x); x += dppf<0x141>(x); return x; }
__device__ __forceinline__ void unpack8(u32x4 w, float* f) {
    f[0] = lo_bf(w.x); f[1] = hi_bf(w.x); f[2] = lo_bf(w.y); f[3] = hi_bf(w.y); f[4] = lo_bf(w.z); f[5] = hi_bf(w.z); f[6] = lo_bf(w.w); f[7] = hi_bf(w.w);
}

__device__ __forceinline__ void tr_cvt(const float* __restrict__ src, int K, int N, u16* __restrict__ dst, int& base, float* tile) {
    const int tid = opaque_tid();
    const int tn = N >> 7, tk = K >> 6, nt = tn * tk;
    const int G = gridDim.x;
    const int start = (int)((blockIdx.x + G - (base % G)) % G);
    for (int t = start; t < nt; t += G) {
        const int k0 = (t / tn) << 6, n0 = (t % tn) << 7;
        __syncthreads();
        {
            const int r = tid >> 5, c = (tid & 31) << 2;
            f32x4 v[4];
#pragma unroll
            for (int q = 0; q < 4; ++q) v[q] = *(const f32x4*)(src + (size_t)(k0 + r + q * 16) * N + n0 + c);
#pragma unroll
            for (int q = 0; q < 4; ++q)
#pragma unroll
                for (int e = 0; e < 4; ++e) tile[(r + q * 16) * 129 + c + e] = v[q][e];
        }
        __syncthreads();
        {
            const int n = tid >> 2, k16 = (tid & 3) << 4;
            float v[16];
#pragma unroll
            for (int e = 0; e < 16; ++e) v[e] = tile[(k16 + e) * 129 + n];
            u32x4 w0, w1;
            w0.x = pk_bf16(v[0], v[1]); w0.y = pk_bf16(v[2], v[3]); w0.z = pk_bf16(v[4], v[5]); w0.w = pk_bf16(v[6], v[7]);
            w1.x = pk_bf16(v[8], v[9]); w1.y = pk_bf16(v[10], v[11]); w1.z = pk_bf16(v[12], v[13]); w1.w = pk_bf16(v[14], v[15]);
            u16* dp = dst + (size_t)(n0 + n) * K + k0 + k16;
            *(u32x4*)dp = w0; *(u32x4*)(dp + 8) = w1;
        }
    }
    base += nt;
}

template <bool TO_BF16>
__device__ __forceinline__ void rms_rows(const float* xp, const float* xs, const float* __restrict__ g, u16* h, float* yo) {
    const int tid_ = opaque_tid(); const int wid = tid_ >> 6, lane = tid_ & 63;
    const int stride = gridDim.x * 8;
    for (int row0 = blockIdx.x * 8 + wid; row0 < M; row0 += 2 * stride) {
        const int rowB = row0 + stride; const bool hasB = rowB < M;
        const float* srcA = row0 < MP ? xp + (size_t)row0 * D : xs + (size_t)(row0 - MP) * D;
        const float* srcB = hasB ? (rowB < MP ? xp + (size_t)rowB * D : xs + (size_t)(rowB - MP) * D) : srcA;
        f32x4 va[8], vb[8]; float sa = 0.f, sb = 0.f;
#pragma unroll
        for (int i = 0; i < 8; ++i) { va[i] = *(const f32x4*)(srcA + i * 256 + lane * 4); vb[i] = *(const f32x4*)(srcB + i * 256 + lane * 4); }
#pragma unroll
        for (int i = 0; i < 8; ++i) { sa += va[i][0] * va[i][0] + va[i][1] * va[i][1] + va[i][2] * va[i][2] + va[i][3] * va[i][3];
                                      sb += vb[i][0] * vb[i][0] + vb[i][1] * vb[i][1] + vb[i][2] * vb[i][2] + vb[i][3] * vb[i][3]; }
        sa = wave_sum(sa); sb = wave_sum(sb);
        const float ra = rsqrtf(sa * (1.0f / D) + 1e-6f), rb = rsqrtf(sb * (1.0f / D) + 1e-6f);
#pragma unroll
        for (int i = 0; i < 8; ++i) {
            const f32x4 gg = *(const f32x4*)(g + i * 256 + lane * 4);
            f32x4 oa, ob;
#pragma unroll
            for (int e = 0; e < 4; ++e) { oa[e] = va[i][e] * ra * gg[e]; ob[e] = vb[i][e] * rb * gg[e]; }
            if (TO_BF16) {
                u32x2 w; w.x = pk_bf16(oa[0], oa[1]); w.y = pk_bf16(oa[2], oa[3]); *(u32x2*)(h + (size_t)row0 * D + i * 256 + lane * 4) = w;
                if (hasB) { w.x = pk_bf16(ob[0], ob[1]); w.y = pk_bf16(ob[2], ob[3]); *(u32x2*)(h + (size_t)rowB * D + i * 256 + lane * 4) = w; }
            } else {
                *(f32x4*)(yo + (size_t)row0 * D + i * 256 + lane * 4) = oa;
                if (hasB) *(f32x4*)(yo + (size_t)rowB * D + i * 256 + lane * 4) = ob;
            }
        }
    }
}

constexpr int BM = 256, BK = 64, HALF = 128, HTB = HALF * BK * 2;
__device__ __forceinline__ int lds_byte(int r, int c) { const int st = (r >> 4) * 2 + (c >> 5), rr = r & 15, cc = c & 31, ob = rr * 64 + cc * 2; return st * 1024 + (ob ^ (((ob >> 9) & 1) << 5)); }
__device__ __forceinline__ void stage_rc(int b, int& R, int& C) { const int st = b / 1024, sb = b % 1024, swz = sb ^ (((sb >> 9) & 1) << 5); R = (st >> 1) * 16 + swz / 64; C = (st & 1) * 32 + (swz % 64) / 2; }
__device__ __forceinline__ int perm32(int rho) { const int n = rho >> 4, i = rho & 15; return 8 * (i >> 2) + 4 * n + (i & 3); }
struct Unit { int pm, pn, z; };

template <class Epi, class Sched>
__device__ __forceinline__ void gemm_phase(LAS unsigned char* lds, const int K, const int lda, Sched& S, const Epi& E) {
    const int tid = opaque_tid(), wid = __builtin_amdgcn_readfirstlane(tid >> 6), lane = tid & 63, wr = wid >> 2, wc = wid & 3, fr = lane & 15, fq = lane >> 4;
    const int nt = K / BK;
    unsigned voffA[2], voffB[2];
#pragma unroll
    for (int i = 0; i < 2; ++i) { int R, C; stage_rc(tid * 16 + i * 8192, R, C); const int Rb = (R & ~31) + perm32(R & 31);
        voffA[i] = (unsigned)(R * lda + C) * 2u; voffB[i] = (unsigned)(Rb * K + C) * 2u; }
    const size_t kstep = (size_t)(BK * 2);
    const size_t hstepA = (size_t)HALF * lda * 2, hstepB = (size_t)HALF * K * 2;
    const unsigned ldsw = (unsigned)wid * 1024u;
    const int aoff = lds_byte(wr * 64 + fr, fq * 8), boff = lds_byte(wc * 32 + fr, fq * 8);
#define PG8_SA(b, h) (((b) * 2 + (h)) * HTB)
#define PG8_SB(b, h) ((4 + (b) * 2 + (h)) * HTB)
#define PG8_STAGE(bufoff, gbase, voff) do { _Pragma("unroll") for (int _i = 0; _i < 2; ++_i) \
        __builtin_amdgcn_global_load_lds((const unsigned*)((const char*)(gbase) + (voff)[_i]), (LAS unsigned*)(lds + (bufoff) + ldsw + _i * 8192), 16, 0, 0); } while (0)
#define PG8_LDA(dst, b, h) do { _Pragma("unroll") for (int m = 0; m < 4; ++m) _Pragma("unroll") for (int k = 0; k < 2; ++k) dst[m][k] = *(const LAS bf16x8*)(lds + PG8_SA(b, h) + aoff + m * 2048 + k * 1024); } while (0)
#define PG8_LDB(dst, b, h) do { _Pragma("unroll") for (int n = 0; n < 2; ++n) _Pragma("unroll") for (int k = 0; k < 2; ++k) dst[n][k] = *(const LAS bf16x8*)(lds + PG8_SB(b, h) + boff + n * 2048 + k * 1024); } while (0)
#define PG8_MMA(ai, bj, At, Bt) do { __builtin_amdgcn_s_setprio(1); _Pragma("unroll") for (int m = 0; m < 4; ++m) _Pragma("unroll") for (int n = 0; n < 2; ++n) _Pragma("unroll") for (int k = 0; k < 2; ++k) \
        acc[ai][bj][m][n] = __builtin_amdgcn_mfma_f32_16x16x32_bf16(Bt[n][k], At[m][k], acc[ai][bj][m][n], 0, 0, 0); __builtin_amdgcn_s_setprio(0); } while (0)
#define PG8_WAIT_V(n) asm volatile("s_waitcnt vmcnt(" #n ")" ::: "memory")
#define PG8_WAIT_L(n) asm volatile("s_waitcnt lgkmcnt(" #n ")" ::: "memory")
#define PG8_BAR __builtin_amdgcn_s_barrier()
#define PG8_SCHED __builtin_amdgcn_sched_barrier(0)
    Unit cur, nxt; int ui = 0;
    if (!S.next(0, cur)) return;
    f32x4 acc[2][2][4][2];
#pragma unroll
    for (int a = 0; a < 2; ++a)
#pragma unroll
        for (int b = 0; b < 2; ++b)
#pragma unroll
            for (int m = 0; m < 4; ++m)
#pragma unroll
                for (int n = 0; n < 2; ++n) acc[a][b][m][n] = (f32x4){0.f, 0.f, 0.f, 0.f};
    bf16x8 At[4][2], B0[2][2], B1[2][2];
    const char* cA = S.aptr(cur); const char* cB = S.bptr(cur);
    PG8_STAGE(PG8_SB(0, 0), cB, voffB); PG8_STAGE(PG8_SA(0, 0), cA, voffA); PG8_STAGE(PG8_SB(0, 1), cB + hstepB, voffB); PG8_STAGE(PG8_SA(0, 1), cA + hstepA, voffA);
    if (wr == 1) PG8_BAR;
    PG8_WAIT_V(4); PG8_BAR;
    PG8_STAGE(PG8_SB(1, 0), cB + kstep, voffB); PG8_STAGE(PG8_SA(1, 0), cA + kstep, voffA); PG8_STAGE(PG8_SB(1, 1), cB + hstepB + kstep, voffB);
    PG8_WAIT_V(6); PG8_BAR;
    for (;;) {
        const bool has_next = S.next(ui + 1, nxt);
        const char* nA = has_next ? S.aptr(nxt) : cA; const char* nB = has_next ? S.bptr(nxt) : cB;
        for (int t = 0; t < nt; t += 2) {
            const bool last = (t == nt - 2);
            const char* a1 = cA + (size_t)(t + 1) * kstep;
            const char* a2 = last ? nA : cA + (size_t)(t + 2) * kstep; const char* b2 = last ? nB : cB + (size_t)(t + 2) * kstep;
            const char* a3 = a2 + kstep; const char* b3 = b2 + kstep;
            PG8_LDB(B0, 0, 0); PG8_SCHED; PG8_LDA(At, 0, 0); PG8_STAGE(PG8_SA(1, 1), a1 + hstepA, voffA);
            PG8_WAIT_L(8); PG8_BAR; PG8_WAIT_L(0); PG8_MMA(0, 0, At, B0); PG8_BAR; PG8_SCHED;
            PG8_LDB(B1, 0, 1); PG8_STAGE(PG8_SB(0, 0), b2, voffB);
            PG8_BAR; PG8_WAIT_L(0); PG8_MMA(0, 1, At, B1); PG8_BAR;
            PG8_LDA(At, 0, 1); PG8_STAGE(PG8_SA(0, 0), a2, voffA);
            PG8_BAR; PG8_WAIT_L(0); PG8_MMA(1, 0, At, B0); PG8_BAR; PG8_SCHED;
            PG8_STAGE(PG8_SB(0, 1), b2 + hstepB, voffB);
            PG8_WAIT_V(6); PG8_BAR; PG8_MMA(1, 1, At, B1); PG8_BAR;
            PG8_LDB(B0, 1, 0); PG8_SCHED; PG8_LDA(At, 1, 0); PG8_STAGE(PG8_SA(0, 1), a2 + hstepA, voffA);
            PG8_WAIT_L(8); PG8_BAR; PG8_WAIT_L(0); PG8_MMA(0, 0, At, B0); PG8_BAR; PG8_SCHED;
            PG8_LDB(B1, 1, 1); PG8_STAGE(PG8_SB(1, 0), b3, voffB);
            PG8_BAR; PG8_WAIT_L(0); PG8_MMA(0, 1, At, B1); PG8_BAR;
            PG8_LDA(At, 1, 1); PG8_STAGE(PG8_SA(1, 0), a3, voffA);
            PG8_BAR; PG8_WAIT_L(0); PG8_MMA(1, 0, At, B0); PG8_BAR; PG8_SCHED;
            PG8_STAGE(PG8_SB(1, 1), b3 + hstepB, voffB);
            PG8_WAIT_V(6); PG8_BAR; PG8_MMA(1, 1, At, B1); PG8_BAR;
        }
        E(acc, cur, wr, wc, fr, fq);
        if (!has_next) break;
        if (E.zero_after(cur))
#pragma unroll
        for (int a = 0; a < 2; ++a)
#pragma unroll
            for (int b = 0; b < 2; ++b)
#pragma unroll
                for (int m = 0; m < 4; ++m)
#pragma unroll
                    for (int n = 0; n < 2; ++n) acc[a][b][m][n] = (f32x4){0.f, 0.f, 0.f, 0.f};
        cur = nxt; cA = nA; cB = nB; ++ui;
    }
    PG8_WAIT_V(0);
    if (wr == 0) PG8_BAR;
    PG8_BAR;
#undef PG8_SA
#undef PG8_SB
#undef PG8_STAGE
#undef PG8_LDA
#undef PG8_LDB
#undef PG8_MMA
#undef PG8_WAIT_V
#undef PG8_WAIT_L
#undef PG8_BAR
#undef PG8_SCHED
}

__device__ __forceinline__ int xcd_remap(int L, int nwg) {
    const int q = nwg >> 3, r = nwg & 7, xcd = L & 7, off = L >> 3;
    return (xcd < r ? xcd * (q + 1) : r * (q + 1) + (xcd - r) * q) + off;
}
__device__ __forceinline__ void map_tile(int L, int nq, int nM, int& pm, int& q) {
    const int nig = 8 * nq, gid = L / nig, fm = gid * 8, gsz = (nM - fm) < 8 ? (nM - fm) : 8;
    pm = fm + ((L % nig) % gsz); q = (L % nig) / gsz;
}
struct SchedIn {
    const u16* A; const u16* Bt; int set; unsigned* ctr; LAS int* slot; int G, c; int steal; bool t0;
    __device__ __forceinline__ bool next(int i, Unit& u) {
        const int nq = set == 0 ? 18 : 41, nwg = 65 * nq;
        int L;
        if (ctr) {
            if (t0) {
                const int q8 = nwg >> 3, r8 = nwg & 7;
                int res = nwg;
                while (steal < 8) {
                    const int x = (c + steal) & 7;
                    const int cnt = q8 + (x < r8 ? 1 : 0), base = x < r8 ? x * (q8 + 1) : r8 * (q8 + 1) + (x - r8) * q8;
                    const int v = (int)atomicAdd(ctr + x, 1u);
                    if (v < cnt) { res = base + v; break; }
                    ++steal;
                }
                slot[i & 1] = res; asm volatile("s_waitcnt lgkmcnt(0)" ::: "memory");
            }
            __builtin_amdgcn_s_barrier();
            asm volatile("" ::: "memory");
            L = slot[i & 1];
            if (L >= nwg) return false;
        } else { L = i * G + c; if (L >= nwg) return false; L = xcd_remap(L, nwg); }
        int q; map_tile(L, nq, 65, u.pm, q);
        if (set == 0) u.pn = q < 13 ? 4 + q : 26 + (q - 13);
        else u.pn = q < 4 ? q : (q < 13 ? 17 + (q - 4) : 31 + (q - 13));
        u.z = 0; return true;
    }
    __device__ __forceinline__ const char* aptr(const Unit& u) const { return (const char*)(A + (size_t)u.pm * 256 * 2048); }
    __device__ __forceinline__ const char* bptr(const Unit& u) const { return (const char*)(Bt + (size_t)u.pn * 256 * 2048); }
};
struct SchedBr {
    const u16* A; const u16* Bt; int G, c;
    __device__ __forceinline__ bool next(int i, Unit& u) {
        int L = (i / 3) * G + c; if (L >= 64 * 8) return false;
        L = xcd_remap(L, 64 * 8);
        map_tile(L, 8, 64, u.pm, u.pn); u.z = i % 3; return true;
    }
    __device__ __forceinline__ const char* aptr(const Unit& u) const { return (const char*)(A + (size_t)u.pm * 256 * NIN + OFF_GATE + u.z * 1024); }
    __device__ __forceinline__ const char* bptr(const Unit& u) const { return (const char*)(Bt + (size_t)u.z * 2048 * 1024 + (size_t)u.pn * 256 * 1024); }
};
struct SchedOut {
    const u16* A; const u16* Bt; int G, c;
    __device__ __forceinline__ bool next(int i, Unit& u) {
        int L = i * G + c; if (L >= 64 * 8) return false;
        L = xcd_remap(L, 64 * 8);
        map_tile(L, 8, 64, u.pm, u.pn); u.z = 0; return true;
    }
    __device__ __forceinline__ const char* aptr(const Unit& u) const { return (const char*)(A + (size_t)u.pm * 256 * 2048); }
    __device__ __forceinline__ const char* bptr(const Unit& u) const { return (const char*)(Bt + (size_t)u.pn * 256 * 2048); }
};

struct EpiIn {
    u16* proj;
    __device__ __forceinline__ bool zero_after(const Unit&) const { return true; }
    __device__ __forceinline__ void operator()(f32x4 (&acc)[2][2][4][2], const Unit& u, int wr, int wc, int fr, int fq) const {
#pragma unroll
        for (int bj = 0; bj < 2; ++bj) {
            const int colb = u.pn * 256 + bj * 128;
            if (colb >= NIN) continue;
            const int act = colb >= OFF_MERGE ? 2 : (colb >= OFF_GATE ? 1 : 0);
            u16* pb = proj + (size_t)(u.pm * 256 + wr * 64 + fr) * NIN + colb + wc * 32 + 8 * fq;
#pragma unroll
            for (int ai = 0; ai < 2; ++ai)
#pragma unroll
                for (int m = 0; m < 4; ++m) {
                    f32x4 v0 = acc[ai][bj][m][0], v1 = acc[ai][bj][m][1];
                    if (act == 1) {
#pragma unroll
                        for (int j = 0; j < 4; ++j) { v0[j] = v0[j] * sigm(v0[j]); v1[j] = v1[j] * sigm(v1[j]); }
                    } else if (act == 2) {
#pragma unroll
                        for (int j = 0; j < 4; ++j) { v0[j] = sigm(v0[j]); v1[j] = sigm(v1[j]); }
                    }
                    u32x4 w; w.x = pk_bf16(v0[0], v0[1]); w.y = pk_bf16(v0[2], v0[3]); w.z = pk_bf16(v1[0], v1[1]); w.w = pk_bf16(v1[2], v1[3]);
                    *(u32x4*)(pb + (size_t)(ai * 128 + m * 16) * NIN) = w;
                }
        }
    }
};
__device__ __forceinline__ void side_outputs(const Params& P, int l, int nblk, int blk) {
    const u16* proj = (const u16*)(P.ws + WS_PROJ);
    float* out = P.out;
    const int nthr = nblk * 512, gt = blk * 512 + opaque_tid();
    for (int i = gt; i < 4 * 15 * 1024; i += nthr) { const int c = i & 1023, j = (i >> 10) % 15, b = i / (15 * 1024);
        out[O_PLP + (size_t)l * 4 * 15 * 1024 + i] = bf2f(proj[((size_t)b * 4096 + 4081 + j) * NIN + c]); }
    for (int i = gt; i < 16 * 15 * 1024; i += nthr) { const int c = i & 1023, j = (i >> 10) % 15, b = i / (15 * 1024);
        out[O_PLS + (size_t)l * 16 * 15 * 1024 + i] = bf2f(proj[((size_t)MP + b * 16 + 1 + j) * NIN + c]); }
    for (int i = gt; i < 4 * SHIFT_W; i += nthr) { const int c = i % SHIFT_W, b = i / SHIFT_W;
        out[O_SHP + (size_t)l * 4 * SHIFT_W + i] = bf2f(proj[((size_t)b * 4096 + 4095) * NIN + OFF_SHIFT + c]); }
    for (int i = gt; i < 16 * SHIFT_W; i += nthr) { const int c = i % SHIFT_W, b = i / SHIFT_W;
        out[O_SHS + (size_t)l * 16 * SHIFT_W + i] = bf2f(proj[((size_t)MP + b * 16 + 15) * NIN + OFF_SHIFT + c]); }
    for (int i = gt; i < 4 * 128 * 256; i += nthr) { const int c = i & 255, t = (i >> 8) & 127, b = i >> 15;
        const size_t r = ((size_t)b * 4096 + 3968 + t) * NIN;
        out[O_KP + (size_t)l * 4 * 128 * 256 + i] = bf2f(proj[r + OFF_K + c]); out[O_VP + (size_t)l * 4 * 128 * 256 + i] = bf2f(proj[r + OFF_V + c]); }
    for (int i = gt; i < 16 * 16 * 256; i += nthr) { const int c = i & 255, t = (i >> 8) & 15, b = i >> 12;
        const size_t r = ((size_t)MP + b * 16 + t) * NIN;
        out[O_KS + (size_t)l * 16 * 16 * 256 + i] = bf2f(proj[r + OFF_K + c]); out[O_VS + (size_t)l * 16 * 16 * 256 + i] = bf2f(proj[r + OFF_V + c]); }
}
struct EpiBr {
    const u16* proj; u16* merged;
    __device__ __forceinline__ bool zero_after(const Unit& u) const { return u.z == 2; }
    __device__ __forceinline__ void operator()(f32x4 (&acc)[2][2][4][2], const Unit& u, int wr, int wc, int fr, int fq) const {
        const int b = u.z;
        const u16* gbase = proj + (size_t)(u.pm * 256 + wr * 64 + fr) * NIN + OFF_MERGE + b * 2048 + u.pn * 256 + wc * 32 + 8 * fq;
        u16* mbase = merged + (size_t)(u.pm * 256 + wr * 64 + fr) * 2048 + u.pn * 256 + wc * 32 + 8 * fq;
#pragma unroll
        for (int ai = 0; ai < 2; ++ai) {
            u32x4 g[4][2], gn[4][2];
#pragma unroll
            for (int m = 0; m < 4; ++m)
#pragma unroll
                for (int bj = 0; bj < 2; ++bj) {
                    const u16* gp = gbase + (size_t)(ai * 128 + m * 16) * NIN + bj * 128;
                    g[m][bj] = *(const u32x4*)gp;
                    if (b < 2) gn[m][bj] = *(const u32x4*)(gp + 2048);
                }
#pragma unroll
            for (int m = 0; m < 4; ++m)
#pragma unroll
                for (int bj = 0; bj < 2; ++bj) {
                    float gf[8]; unpack8(g[m][bj], gf);
                    if (b < 2) {
                        float gd[8]; unpack8(gn[m][bj], gd);
#pragma unroll
                        for (int j = 0; j < 8; ++j) gf[j] = fmaxf(gf[j], 1e-20f) * __builtin_amdgcn_rcpf(fmaxf(gd[j], 1e-20f));
                    } else {
#pragma unroll
                        for (int j = 0; j < 8; ++j) gf[j] = fmaxf(gf[j], 1e-20f);
                    }
#pragma unroll
                    for (int j = 0; j < 4; ++j) { acc[ai][bj][m][0][j] *= gf[j]; acc[ai][bj][m][1][j] *= gf[4 + j]; }
                    if (b == 2) {
                        const f32x4 v0 = acc[ai][bj][m][0], v1 = acc[ai][bj][m][1];
                        u32x4 w; w.x = pk_bf16(v0[0], v0[1]); w.y = pk_bf16(v0[2], v0[3]); w.z = pk_bf16(v1[0], v1[1]); w.w = pk_bf16(v1[2], v1[3]);
                        *(u32x4*)(mbase + (size_t)(ai * 128 + m * 16) * 2048 + bj * 128) = w;
                    }
                }
        }
    }
};
struct EpiOut {
    const float* xp; const float* xs; float* out;
    __device__ __forceinline__ bool zero_after(const Unit&) const { return true; }
    __device__ __forceinline__ void operator()(f32x4 (&acc)[2][2][4][2], const Unit& u, int wr, int wc, int fr, int fq) const {
        const int r0 = u.pm * 256 + wr * 64 + fr, c0 = u.pn * 256 + wc * 32 + 8 * fq;
        const float* src = (r0 < MP ? xp + (size_t)r0 * D : xs + (size_t)(r0 - MP) * D) + c0;
        float* dst = out + (size_t)r0 * D + c0;
#pragma unroll
        for (int ai = 0; ai < 2; ++ai) {
            f32x4 x[4][2][2];
#pragma unroll
            for (int m = 0; m < 4; ++m)
#pragma unroll
                for (int bj = 0; bj < 2; ++bj) {
                    const float* sp = src + (size_t)(ai * 128 + m * 16) * D + bj * 128;
                    x[m][bj][0] = *(const f32x4*)sp; x[m][bj][1] = *(const f32x4*)(sp + 4);
                }
#pragma unroll
            for (int m = 0; m < 4; ++m)
#pragma unroll
                for (int bj = 0; bj < 2; ++bj) {
                    float* dp = dst + (size_t)(ai * 128 + m * 16) * D + bj * 128;
                    *(f32x4*)dp = x[m][bj][0] + acc[ai][bj][m][0];
                    *(f32x4*)(dp + 4) = x[m][bj][1] + acc[ai][bj][m][1];
                }
        }
    }
};

template <int K>
__device__ __forceinline__ f32x4 small_pass(const u16* A, int lda, const u16* Bt, unsigned char* smem) {
    const int tid = opaque_tid(), w = tid >> 6, lane = tid & 63, fr = lane & 15, fq = lane >> 4;
    float* red = (float*)smem;
    constexpr int kp = K >> 3; const int k0 = w * kp;
    f32x4 acc[2][4];
#pragma unroll
    for (int a = 0; a < 2; ++a)
#pragma unroll
        for (int b = 0; b < 4; ++b) acc[a][b] = (f32x4){0.f, 0.f, 0.f, 0.f};
#pragma unroll
    for (int ks = 0; ks < (kp >> 5); ++ks) {
        const int kk = k0 + ks * 32 + fq * 8;
        bf16x8 af[2], bfr[4];
#pragma unroll
        for (int mb = 0; mb < 2; ++mb) af[mb] = *(const bf16x8*)(A + (size_t)(mb * 16 + fr) * lda + kk);
#pragma unroll
        for (int nb = 0; nb < 4; ++nb) bfr[nb] = *(const bf16x8*)(Bt + (size_t)(nb * 16 + fr) * K + kk);
#pragma unroll
        for (int mb = 0; mb < 2; ++mb)
#pragma unroll
            for (int nb = 0; nb < 4; ++nb) acc[mb][nb] = __builtin_amdgcn_mfma_f32_16x16x32_bf16(bfr[nb], af[mb], acc[mb][nb], 0, 0, 0);
    }
    __syncthreads();
#pragma unroll
    for (int mb = 0; mb < 2; ++mb)
#pragma unroll
        for (int nb = 0; nb < 4; ++nb) *(f32x4*)(red + w * 2048 + (mb * 16 + fr) * 64 + nb * 16 + fq * 4) = acc[mb][nb];
    __syncthreads();
    f32x4 s = {0.f, 0.f, 0.f, 0.f};
#pragma unroll
    for (int ww = 0; ww < 8; ++ww) s += *(const f32x4*)(red + ww * 2048 + tid * 4);
    return s;
}
__device__ __forceinline__ void branch_small(const Params& P, int l, int tile, unsigned char* smem) {
    const int tid = opaque_tid();
    const int R0 = MP + (tile & 7) * 32, N0 = (tile >> 3) * 64;
    const u16* proj = (const u16*)(P.ws + WS_PROJ);
    const u16* wtbr = (const u16*)(P.ws + WS_WTBR) + (size_t)l * 3 * 2048 * 1024;
    const int row = R0 + (tid >> 4), col = N0 + (tid & 15) * 4;
    f32x4 tot = {0.f, 0.f, 0.f, 0.f};
#pragma unroll 1
    for (int z = 0; z < 3; ++z) {
        const f32x4 s = small_pass<1024>(proj + (size_t)R0 * NIN + OFF_GATE + z * 1024, NIN, wtbr + (size_t)z * 2048 * 1024 + (size_t)N0 * 1024, smem);
        const u32x2 g = *(const u32x2*)(proj + (size_t)row * NIN + OFF_MERGE + z * 2048 + col);
        tot[0] += lo_bf(g.x) * s[0]; tot[1] += hi_bf(g.x) * s[1]; tot[2] += lo_bf(g.y) * s[2]; tot[3] += hi_bf(g.y) * s[3];
    }
    u32x2 o; o.x = pk_bf16(tot[0], tot[1]); o.y = pk_bf16(tot[2], tot[3]);
    *(u32x2*)((u16*)(P.ws + WS_H) + (size_t)row * 2048 + col) = o;
}
__device__ __forceinline__ void out_small(const Params& P, int l, int tile, unsigned char* smem) {
    const int tid = opaque_tid();
    const int R0 = MP + (tile & 7) * 32, N0 = (tile >> 3) * 64;
    const u16* merged = (const u16*)(P.ws + WS_H);
    const u16* wtout = (const u16*)(P.ws + WS_WTOUT) + (size_t)l * 2048 * 2048;
    const int row = R0 + (tid >> 4), col = N0 + (tid & 15) * 4;
    const f32x4 s = small_pass<2048>(merged + (size_t)R0 * 2048, 2048, wtout + (size_t)N0 * 2048, smem);
    const float* src = l == 0 ? P.in[1] + (size_t)(row - MP) * D + col : P.out + (size_t)row * D + col;
    const f32x4 x = *(const f32x4*)src;
    *(f32x4*)(P.out + (size_t)row * D + col) = x + s;
}

template <int NMB>
__device__ __forceinline__ void rwkv_prep_tile(const Params& P, int l, int Rbase, unsigned char* smem) {
    const int tid = opaque_tid(), w = tid >> 6, lane = tid & 63, fr = lane & 15, fq = lane >> 4;
    u16* A1 = (u16*)smem; u16* A2 = A1 + 64 * 72;
    const u16* proj = (const u16*)(P.ws + WS_PROJ);
    const float* mu = P.in[11] + (size_t)l * SHIFT_W;
    __syncthreads();
    if (tid < NMB * 128) {
        const int tok = tid >> 3, seg = (tid & 7) * 16;
        const int R = Rbase + tok;
        bool first; const float* st = nullptr;
        if (R < MP) first = (R & 4095) == 0;
        else { const int rs = R - MP; first = (rs & 15) == 0; st = P.in[5] + (size_t)(l * 16 + (rs >> 4)) * SHIFT_W; }
        const u16* pc = proj + (size_t)R * NIN + OFF_SHIFT + 3072 + seg;
        float cur[16], prv[16];
        unpack8(*(const u32x4*)pc, cur); unpack8(*(const u32x4*)(pc + 8), cur + 8);
        if (!first) { unpack8(*(const u32x4*)(pc - NIN), prv); unpack8(*(const u32x4*)(pc - NIN + 8), prv + 8); }
        else {
#pragma unroll
            for (int e = 0; e < 16; ++e) prv[e] = st ? st[3072 + seg + e] : 0.f;
        }
        float xs[16];
#pragma unroll
        for (int e = 0; e < 16; ++e) { xs[e] = cur[e] + (prv[e] - cur[e]) * mu[3072 + seg + e]; if (seg < 64) xs[e] = tanhf(xs[e]); }
        u16* dstp = seg < 64 ? A1 + tok * 72 + seg : A2 + tok * 72 + (seg - 64);
        u32x4 w0, w1;
        w0.x = pk_bf16(xs[0], xs[1]); w0.y = pk_bf16(xs[2], xs[3]); w0.z = pk_bf16(xs[4], xs[5]); w0.w = pk_bf16(xs[6], xs[7]);
        w1.x = pk_bf16(xs[8], xs[9]); w1.y = pk_bf16(xs[10], xs[11]); w1.z = pk_bf16(xs[12], xs[13]); w1.w = pk_bf16(xs[14], xs[15]);
        *(u32x4*)dstp = w0; *(u32x4*)(dstp + 8) = w1;
    }
    __syncthreads();
    float* decay = (float*)(P.ws + WS_DEC); float* aa = (float*)(P.ws + WS_AA);
#pragma unroll 1
    for (int mat = 0; mat < 2; ++mat) {
        const u16* A = mat ? A2 : A1;
        const u16* Wt = (const u16*)(P.ws + (mat ? WS_AUPT : WS_WUPT)) + (size_t)l * 1024 * 64;
        const float* bias = (mat ? P.in[14] : P.in[12]) + (size_t)l * 1024;
        float* dstm = mat ? aa : decay;
        bf16x8 af[NMB][2];
#pragma unroll
        for (int mb = 0; mb < NMB; ++mb)
#pragma unroll
            for (int ks = 0; ks < 2; ++ks) af[mb][ks] = *(const bf16x8*)(A + (mb * 16 + fr) * 72 + ks * 32 + fq * 8);
#pragma unroll 2
        for (int nb = 0; nb < 8; ++nb) {
            const int n = w * 128 + nb * 16 + fr;
            bf16x8 bfr[2];
#pragma unroll
            for (int ks = 0; ks < 2; ++ks) bfr[ks] = *(const bf16x8*)(Wt + (size_t)n * 64 + ks * 32 + fq * 8);
            const int c = w * 128 + nb * 16 + fq * 4;
            const f32x4 bi = *(const f32x4*)(bias + c);
#pragma unroll
            for (int mb = 0; mb < NMB; ++mb) {
                f32x4 a = {0.f, 0.f, 0.f, 0.f};
#pragma unroll
                for (int ks = 0; ks < 2; ++ks) a = __builtin_amdgcn_mfma_f32_16x16x32_bf16(bfr[ks], af[mb][ks], a, 0, 0, 0);
                const int R = Rbase + mb * 16 + fr;
                f32x4 o;
#pragma unroll
                for (int j = 0; j < 4; ++j) { const float s = sigm(bi[j] + a[j]); o[j] = mat ? s : __expf(-0.60653066f * s); }
                *(f32x4*)(dstm + (size_t)R * 1024 + c) = o;
            }
        }
    }
}

typedef float f32x2 __attribute__((ext_vector_type(2)));
__device__ __forceinline__ void scan_item(const Params& P, int l, int v, unsigned char* smem, const int c0 = 0, int c1 = -1, const bool resume = false) {
    const int tid = opaque_tid(), w = tid >> 6, lane = tid & 63;
    float* sm = (float*)smem;
    float* bufs = sm;
    float* ybuf = sm + 2 * 16 * 384;
    const bool samp = v >= 64;
    int b, h, T; size_t row0;
    { const int chain = samp ? v - 64 : v; b = chain >> 4; h = chain & 15; }
    if (!samp) { T = 4096; row0 = (size_t)b * 4096; } else { T = 16; row0 = (size_t)MP + (size_t)b * 16; }
    const int nch = (c1 < 0 || c1 > (T >> 4)) ? (T >> 4) : c1;
    const u16* proj = (const u16*)(P.ws + WS_PROJ);
    __syncthreads();
    if (w < 4) {
        const int i0 = w * 16 + (lane >> 3), i1 = i0 + 8, js = (lane & 7) * 8;
        f32x2 S0, S1, S2, S3, T0, T1, T2, T3;
        if (samp) {
            const float* s0 = P.in[4] + ((size_t)(l * 16 + b) * 16 + h) * 4096 + js;
            const f32x4 a0 = *(const f32x4*)(s0 + i0 * 64), a1 = *(const f32x4*)(s0 + i0 * 64 + 4), c0 = *(const f32x4*)(s0 + i1 * 64), c1 = *(const f32x4*)(s0 + i1 * 64 + 4);
            S0 = a0.xy; S1 = a0.zw; S2 = a1.xy; S3 = a1.zw; T0 = c0.xy; T1 = c0.zw; T2 = c1.xy; T3 = c1.zw;
        } else if (resume) {
            const float* s0 = P.out + O_RP + ((size_t)(l * 4 + b) * 16 + h) * 4096 + js;
            const f32x4 a0 = *(const f32x4*)(s0 + i0 * 64), a1 = *(const f32x4*)(s0 + i0 * 64 + 4), c0v = *(const f32x4*)(s0 + i1 * 64), c1v = *(const f32x4*)(s0 + i1 * 64 + 4);
            S0 = a0.xy; S1 = a0.zw; S2 = a1.xy; S3 = a1.zw; T0 = c0v.xy; T1 = c0v.zw; T2 = c1v.xy; T3 = c1v.zw;
        } else { S0 = (f32x2){0.f, 0.f}; S1 = S0; S2 = S0; S3 = S0; T0 = S0; T1 = S0; T2 = S0; T3 = S0; }
        __syncthreads();
        for (int c = c0; c < nch; ++c) {
            const float* bb = bufs + (c & 1) * (16 * 384) + js;
            const float* bv = bufs + (c & 1) * (16 * 384) + 320 + i0;
            float* yb = ybuf + (c & 1) * 8192 + w * 64 + lane;
            f32x4 w0, w1, a0, a1, b0, b1, k0, k1, r0, r1; float vi, vj;
            f32x4 W0, W1, A0, A1, B0, B1, K0, K1, R0, R1; float VI, VJ;
#define SCAN_LOAD(w0, w1, a0, a1, b0, b1, k0, k1, r0, r1, vi, vj, t) do { const float* vb = bb + (t) * 384; \
                w0 = *(const f32x4*)(vb); w1 = *(const f32x4*)(vb + 4); a0 = *(const f32x4*)(vb + 64); a1 = *(const f32x4*)(vb + 68); \
                b0 = *(const f32x4*)(vb + 128); b1 = *(const f32x4*)(vb + 132); k0 = *(const f32x4*)(vb + 192); k1 = *(const f32x4*)(vb + 196); \
                r0 = *(const f32x4*)(vb + 256); r1 = *(const f32x4*)(vb + 260); vi = bv[(t) * 384]; vj = bv[(t) * 384 + 8]; } while (0)
#define SCAN_ROW(S0, S1, S2, S3, w0, w1, a0, a1, b0, b1, k0, k1, r0, r1, vi, yslot) do { const f32x2 vi2 = {vi, vi}; \
                f32x2 p = S0 * a0.xy; p = S1 * a0.zw + p; f32x2 q = S2 * a1.xy; q = S3 * a1.zw + q; \
                const f32x2 sw0 = S0 * w0.xy + vi2 * k0.xy, sw1 = S1 * w0.zw + vi2 * k0.zw, sw2 = S2 * w1.xy + vi2 * k1.xy, sw3 = S3 * w1.zw + vi2 * k1.zw; \
                p = p + q; const float dot = red8(p.x + p.y); const f32x2 d2 = {dot, dot}; \
                S0 = d2 * b0.xy + sw0; S1 = d2 * b0.zw + sw1; S2 = d2 * b1.xy + sw2; S3 = d2 * b1.zw + sw3; \
                f32x2 yp = S0 * r0.xy; yp = S1 * r0.zw + yp; f32x2 yq = S2 * r1.xy; yq = S3 * r1.zw + yq; yp = yp + yq; \
                yb[yslot] = yp.x + yp.y; } while (0)
#define SCAN_STEP(w0, w1, a0, a1, b0, b1, k0, k1, r0, r1, vi, vj, t) do { \
                SCAN_ROW(S0, S1, S2, S3, w0, w1, a0, a1, b0, b1, k0, k1, r0, r1, vi, (t) * 512); \
                SCAN_ROW(T0, T1, T2, T3, w0, w1, a0, a1, b0, b1, k0, k1, r0, r1, vj, (t) * 512 + 256); } while (0)
            SCAN_LOAD(w0, w1, a0, a1, b0, b1, k0, k1, r0, r1, vi, vj, 0);
#pragma unroll
            for (int t = 0; t < 16; t += 2) {
                SCAN_LOAD(W0, W1, A0, A1, B0, B1, K0, K1, R0, R1, VI, VJ, t + 1);
                SCAN_STEP(w0, w1, a0, a1, b0, b1, k0, k1, r0, r1, vi, vj, t);
                if (t + 2 < 16) SCAN_LOAD(w0, w1, a0, a1, b0, b1, k0, k1, r0, r1, vi, vj, t + 2);
                SCAN_STEP(W0, W1, A0, A1, B0, B1, K0, K1, R0, R1, VI, VJ, t + 1);
            }
#undef SCAN_LOAD
#undef SCAN_ROW
#undef SCAN_STEP
            __syncthreads();
        }
        float* so = P.out + (samp ? O_RS + ((size_t)(l * 16 + b) * 16 + h) * 4096 : O_RP + ((size_t)(l * 4 + b) * 16 + h) * 4096) + js;
        f32x4 o0, o1; o0.xy = S0; o0.zw = S1; o1.xy = S2; o1.zw = S3;
        *(f32x4*)(so + i0 * 64) = o0; *(f32x4*)(so + i0 * 64 + 4) = o1;
        o0.xy = T0; o0.zw = T1; o1.xy = T2; o1.zw = T3;
        *(f32x4*)(so + i1 * 64) = o0; *(f32x4*)(so + i1 * 64 + 4) = o1;
    } else {
        const int pw = w - 4;
        const float* decay = (const float*)(P.ws + WS_DEC); const float* aa = (const float*)(P.ws + WS_AA);
        float* yraw = (float*)(P.ws + WS_YRAW);
        const int col = h * 64 + lane;
        const float mu_r = P.in[11][(size_t)l * SHIFT_W + col], mu_k = P.in[11][(size_t)l * SHIFT_W + 1024 + col], mu_v = P.in[11][(size_t)l * SHIFT_W + 2048 + col];
        const float c_kk = P.in[16][l * 1024 + col], c_ka = P.in[17][l * 1024 + col];
        const float* sh0 = samp ? P.in[5] + (size_t)(l * 16 + b) * SHIFT_W : nullptr;
        float pr[2][4], pk[2][4], pv[2][4], qr[2][4], qk[2][4], qv[2][4], pd[2][4], pa[2][4];
        auto prep_load = [&](int c, auto SET) {
            constexpr int s = decltype(SET)::value;
#pragma unroll
            for (int u = 0; u < 4; ++u) {
                const int t = c * 16 + pw + u * 4;
                const u16* p = proj + (row0 + t) * NIN + OFF_SHIFT + col;
                pr[s][u] = bf2f(p[0]); pk[s][u] = bf2f(p[1024]); pv[s][u] = bf2f(p[2048]);
                if (t > 0) { qr[s][u] = bf2f(p[-NIN]); qk[s][u] = bf2f(p[1024 - NIN]); qv[s][u] = bf2f(p[2048 - NIN]); }
                else if (sh0) { qr[s][u] = sh0[col]; qk[s][u] = sh0[1024 + col]; qv[s][u] = sh0[2048 + col]; }
                else { qr[s][u] = 0.f; qk[s][u] = 0.f; qv[s][u] = 0.f; }
                pd[s][u] = decay[(row0 + t) * 1024 + col]; pa[s][u] = aa[(row0 + t) * 1024 + col];
            }
        };
        auto prep_store = [&](int c, auto SET) {
            constexpr int s = decltype(SET)::value;
            float* bb = bufs + (c & 1) * (16 * 384);
#pragma unroll
            for (int u = 0; u < 4; ++u) {
                const int tl = pw + u * 4;
                const float xr = pr[s][u] + (qr[s][u] - pr[s][u]) * mu_r, xk = pk[s][u] + (qk[s][u] - pk[s][u]) * mu_k, xv = pv[s][u] + (qv[s][u] - pv[s][u]) * mu_v;
                const float kkr = xk * c_kk;
                const float n2 = wave_sum(kkr * kkr);
                const float kk = kkr / fmaxf(sqrtf(n2), 1e-12f);
                const float kp = xk * (1.f + (pa[s][u] - 1.f) * c_ka);
                float* o = bb + tl * 384 + lane;
                o[0] = pd[s][u]; o[64] = -kk; o[128] = kk * pa[s][u]; o[192] = kp; o[256] = xr; o[320] = xv;
            }
        };
        auto drain = [&](int c) {
            const float* yb = ybuf + (c & 1) * 8192;
            const int pt = tid - 256, t = pt >> 4, rq = pt & 15;
            const float* src = yb + t * 512 + ((rq & 3) >> 1) * 256 + (rq >> 2) * 64 + (rq & 1) * 32;
            f32x4 o;
#pragma unroll
            for (int e = 0; e < 4; ++e) {
                const f32x4 y0 = *(const f32x4*)(src + e * 8), y1 = *(const f32x4*)(src + e * 8 + 4);
                o[e] = ((y0[0] + y0[1]) + (y0[2] + y0[3])) + ((y1[0] + y1[1]) + (y1[2] + y1[3]));
            }
            *(f32x4*)(yraw + (row0 + c * 16 + t) * 1024 + h * 64 + rq * 4) = o;
        };
        using I0 = std::integral_constant<int, 0>; using I1 = std::integral_constant<int, 1>;
        prep_load(c0, I0{}); prep_store(c0, I0{});
        if (c0 + 1 < nch) prep_load(c0 + 1, I1{});
        if (c0 + 2 < nch) prep_load(c0 + 2, I0{});
        __syncthreads();
        for (int c = c0; c < nch; c += 2) {
            if (c + 1 < nch) prep_store(c + 1, I1{});
            if (c + 3 < nch) prep_load(c + 3, I1{});
            if (c > c0) drain(c - 1);
            __syncthreads();
            if (c + 1 < nch) {
                if (c + 2 < nch) prep_store(c + 2, I0{});
                if (c + 4 < nch) prep_load(c + 4, I0{});
                drain(c);
                __syncthreads();
            }
        }
        drain(nch - 1);
    }
}

__device__ __forceinline__ float red16(float x) { x += dppf<0xB1>(x); x += dppf<0x4E>(x); x += dppf<0x141>(x); x += dppf<0x140>(x); return x; }
__device__ __forceinline__ void rwkv_post_rows(const Params& P, int l, int rbeg, int rend) {
    const int tid = opaque_tid(), w = tid >> 6, lane = tid & 63;
    u16* proj = (u16*)(P.ws + WS_PROJ);
    const float* aa = (const float*)(P.ws + WS_AA); const float* yraw = (const float*)(P.ws + WS_YRAW);
    const float* mu = P.in[11] + (size_t)l * SHIFT_W;
#pragma unroll 1
    for (int R = rbeg + w; R < rend; R += 8) {
        bool first; const float* st = nullptr;
        if (R < MP) first = (R & 4095) == 0;
        else { const int rs = R - MP; first = (rs & 15) == 0; st = P.in[5] + (size_t)(l * 16 + (rs >> 4)) * SHIFT_W; }
#pragma unroll
        for (int hq = 0; hq < 4; ++hq) {
            const int col = hq * 256 + lane * 4;
            const u16* p = proj + (size_t)R * NIN + OFF_SHIFT + col;
            const u32x2 cr = *(const u32x2*)p, ck = *(const u32x2*)(p + 1024), cv = *(const u32x2*)(p + 2048);
            float pr[4] = {lo_bf(cr.x), hi_bf(cr.x), lo_bf(cr.y), hi_bf(cr.y)}, pk[4] = {lo_bf(ck.x), hi_bf(ck.x), lo_bf(ck.y), hi_bf(ck.y)},
                  pv[4] = {lo_bf(cv.x), hi_bf(cv.x), lo_bf(cv.y), hi_bf(cv.y)};
            float qr[4], qk[4], qv[4];
            if (!first) {
                const u32x2 dr = *(const u32x2*)(p - NIN), dk = *(const u32x2*)(p + 1024 - NIN), dv = *(const u32x2*)(p + 2048 - NIN);
                qr[0] = lo_bf(dr.x); qr[1] = hi_bf(dr.x); qr[2] = lo_bf(dr.y); qr[3] = hi_bf(dr.y);
                qk[0] = lo_bf(dk.x); qk[1] = hi_bf(dk.x); qk[2] = lo_bf(dk.y); qk[3] = hi_bf(dk.y);
                qv[0] = lo_bf(dv.x); qv[1] = hi_bf(dv.x); qv[2] = lo_bf(dv.y); qv[3] = hi_bf(dv.y);
            } else {
#pragma unroll
                for (int e = 0; e < 4; ++e) { qr[e] = st ? st[col + e] : 0.f; qk[e] = st ? st[1024 + col + e] : 0.f; qv[e] = st ? st[2048 + col + e] : 0.f; }
            }
            const f32x4 mr = *(const f32x4*)(mu + col), mk = *(const f32x4*)(mu + 1024 + col), mv = *(const f32x4*)(mu + 2048 + col);
            const f32x4 a = *(const f32x4*)(aa + (size_t)R * 1024 + col);
            const f32x4 ka = *(const f32x4*)(P.in[17] + l * 1024 + col), rk = *(const f32x4*)(P.in[18] + l * 1024 + col);
            const f32x4 gw = *(const f32x4*)(P.in[19] + l * 1024 + col), gb = *(const f32x4*)(P.in[20] + l * 1024 + col);
            const f32x4 y = *(const f32x4*)(yraw + (size_t)R * 1024 + col);
            float xv[4], bon = 0.f;
#pragma unroll
            for (int e = 0; e < 4; ++e) {
                const float xr = pr[e] + (qr[e] - pr[e]) * mr[e], xk = pk[e] + (qk[e] - pk[e]) * mk[e];
                xv[e] = pv[e] + (qv[e] - pv[e]) * mv[e];
                bon += xr * (xk * (1.f + (a[e] - 1.f) * ka[e])) * rk[e];
            }
            bon = red16(bon);
            const float mean = red16(y[0] + y[1] + y[2] + y[3]) * (1.f / 64.f);
            float d[4], vs = 0.f;
#pragma unroll
            for (int e = 0; e < 4; ++e) { d[e] = y[e] - mean; vs += d[e] * d[e]; }
            const float rstd = rsqrtf(red16(vs) * (1.f / 64.f) + 64e-5f);
            u16* gp = proj + (size_t)R * NIN + OFF_GATE + 1024 + col;
            const u32x2 gz = *(const u32x2*)gp;
            float o[4];
#pragma unroll
            for (int e = 0; e < 4; ++e) o[e] = d[e] * rstd * gw[e] + gb[e] + bon * xv[e];
            u32x2 ow; ow.x = pk_bf16(o[0] * lo_bf(gz.x), o[1] * hi_bf(gz.x)); ow.y = pk_bf16(o[2] * lo_bf(gz.y), o[3] * hi_bf(gz.y));
            *(u32x2*)gp = ow;
        }
    }
}

__device__ __forceinline__ void pool_item(const Params& P, int l, int item, unsigned char* smem) {
    const int tid = opaque_tid(), w = tid >> 6, lane = tid & 63, fr = lane & 15, fq = lane >> 4;
    const int tile = item >> 2, g = item & 3;
    u16* At = (u16*)smem;
    u16* proj = (u16*)(P.ws + WS_PROJ);
    __syncthreads();
    {
        const int cp = tid & 127, tq = tid >> 7;
        const int c = g * 256 + cp * 2;
        auto build = [&](auto WINC) {
            constexpr int WIN = decltype(WINC)::value;
#pragma unroll 1
            for (int sub = 0; sub < 2; ++sub) {
                const int unit = tq * 2 + sub;
                const int R0 = tile * 128 + unit * 16;
                const bool samp = R0 >= MP;
                int t0; const float* hist = nullptr;
                if (!samp) t0 = R0 & 4095; else { t0 = 0; hist = P.in[6] + (size_t)(l * 16 + ((R0 - MP) >> 4)) * 15 * 1024; }
                float u0[WIN - 1 + 16], u1[WIN - 1 + 16];
#pragma unroll
                for (int k = 0; k < WIN - 1 + 16; ++k) {
                    const int dt = k - (WIN - 1), t = t0 + dt;
                    if (t >= 0) { const unsigned wv = *(const unsigned*)(proj + (size_t)(R0 + dt) * NIN + c); u0[k] = lo_bf(wv); u1[k] = hi_bf(wv); }
                    else if (hist) { const float* hp = hist + (size_t)(15 + t) * 1024 + c; u0[k] = hp[0]; u1[k] = hp[1]; }
                    else { u0[k] = 0.f; u1[k] = 0.f; }
                }
                float s0 = 0.f, s1 = 0.f;
#pragma unroll
                for (int k = 0; k < WIN - 1; ++k) { s0 += u0[k]; s1 += u1[k]; }
#pragma unroll
                for (int tt = 0; tt < 16; ++tt) {
                    s0 += u0[WIN - 1 + tt]; s1 += u1[WIN - 1 + tt];
                    const int pos = t0 + tt;
                    const float cnt = samp ? (float)WIN : (float)((pos + 1) < WIN ? (pos + 1) : WIN);
                    const float inv = 1.f / cnt;
                    *(unsigned*)(At + (unit * 16 + tt) * 264 + cp * 2) = pk_bf16(s0 * inv - u0[WIN - 1 + tt], s1 * inv - u1[WIN - 1 + tt]);
                    s0 -= u0[tt]; s1 -= u1[tt];
                }
            }
        };
        if (g == 0) build(std::integral_constant<int, 2>{});
        else if (g == 1) build(std::integral_constant<int, 4>{});
        else if (g == 2) build(std::integral_constant<int, 8>{});
        else build(std::integral_constant<int, 16>{});
    }
    __syncthreads();
    const u16* Wt = (const u16*)(P.ws + WS_WTPOOL) + (size_t)(l * 4 + g) * 65536;
    const int mrow0 = (w & 1) * 64, ncol0 = (w >> 1) * 64;
    f32x4 acc[4][4];
#pragma unroll
    for (int a = 0; a < 4; ++a)
#pragma unroll
        for (int b = 0; b < 4; ++b) acc[a][b] = (f32x4){0.f, 0.f, 0.f, 0.f};
#pragma unroll 2
    for (int ks = 0; ks < 8; ++ks) {
        bf16x8 af[4], bfr[4];
#pragma unroll
        for (int mb = 0; mb < 4; ++mb) af[mb] = *(const bf16x8*)(At + (mrow0 + mb * 16 + fr) * 264 + ks * 32 + fq * 8);
#pragma unroll
        for (int nb = 0; nb < 4; ++nb) bfr[nb] = *(const bf16x8*)(Wt + (size_t)(ncol0 + nb * 16 + fr) * 256 + ks * 32 + fq * 8);
#pragma unroll
        for (int nb = 0; nb < 4; ++nb)
#pragma unroll
            for (int mb = 0; mb < 4; ++mb) acc[nb][mb] = __builtin_amdgcn_mfma_f32_16x16x32_bf16(bfr[nb], af[mb], acc[nb][mb], 0, 0, 0);
    }
    const float* psc = P.in[10] + (size_t)l * 1024;
#pragma unroll
    for (int nb = 0; nb < 4; ++nb) {
        const int colg = g * 256 + ncol0 + nb * 16 + fq * 4;
        const f32x4 sc = *(const f32x4*)(psc + colg);
#pragma unroll
        for (int mb = 0; mb < 4; ++mb) {
            const int R = tile * 128 + mrow0 + mb * 16 + fr;
            u16* gp = proj + (size_t)R * NIN + OFF_GATE + colg;
            const u32x2 gz = *(const u32x2*)gp;
            u32x2 o;
            o.x = pk_bf16(acc[nb][mb][0] * sc[0] * lo_bf(gz.x), acc[nb][mb][1] * sc[1] * hi_bf(gz.x));
            o.y = pk_bf16(acc[nb][mb][2] * sc[2] * lo_bf(gz.y), acc[nb][mb][3] * sc[3] * hi_bf(gz.y));
            *(u32x2*)gp = o;
        }
    }
}

__device__ __forceinline__ int t5_bucket_n(int n) {
    const int ret = n < 0 ? 16 : 0;
    n = n < 0 ? -n : n;
    int v;
    if (n < 8) v = n; else if (n < 12) v = 8; else if (n < 16) v = 9; else if (n < 23) v = 10; else if (n < 32) v = 11;
    else if (n < 46) v = 12; else if (n < 64) v = 13; else if (n < 91) v = 14; else v = 15;
    return ret + v;
}
__device__ __forceinline__ void attn_item(const Params& P, int l, int item, unsigned char* smem) {
    const int tid = opaque_tid(), w = tid >> 6, lane = tid & 63, lq = lane & 31, hh = lane >> 5;
    u16* Ks = (u16*)smem;
    u16* Vt = Ks + 192 * 72;
    float* biasT = (float*)(Vt + 64 * 200);
    u16* proj = (u16*)(P.ws + WS_PROJ);
    const bool samp = item >= 1024;
    int b, nc = 0, kh;
    if (!samp) { b = item >> 8; nc = (item >> 2) & 63; kh = item & 3; } else { const int it = item - 1024; b = it >> 2; kh = it & 3; }
    const size_t qrow0 = samp ? (size_t)MP + (size_t)b * 16 : (size_t)b * 4096 + (size_t)nc * 64;
    __syncthreads();
    for (int idx = tid; idx < 1536; idx += 512) {
        const int s = idx >> 3, d0 = (idx & 7) * 8;
        float kf[8], vf[8];
        bool valid = true, fromproj = true; size_t row = 0;
        if (!samp) { const int tk = nc * 64 - 128 + s; if (tk < 0) valid = false; else row = (size_t)b * 4096 + tk; }
        else { if (s < 128) fromproj = false; else if (s < 144) row = (size_t)MP + (size_t)b * 16 + (s - 128); else valid = false; }
        if (!valid) {
#pragma unroll
            for (int e = 0; e < 8; ++e) { kf[e] = 0.f; vf[e] = 0.f; }
        } else if (fromproj) {
            unpack8(*(const u32x4*)(proj + row * NIN + OFF_K + kh * 64 + d0), kf);
            unpack8(*(const u32x4*)(proj + row * NIN + OFF_V + kh * 64 + d0), vf);
        } else {
            const size_t o = (((size_t)(l * 16 + b) * 128 + s) * 4 + kh) * 64 + d0;
            const f32x4 k0 = *(const f32x4*)(P.in[2] + o), k1 = *(const f32x4*)(P.in[2] + o + 4);
            const f32x4 v0 = *(const f32x4*)(P.in[3] + o), v1 = *(const f32x4*)(P.in[3] + o + 4);
#pragma unroll
            for (int e = 0; e < 4; ++e) { kf[e] = k0[e]; kf[4 + e] = k1[e]; vf[e] = v0[e]; vf[4 + e] = v1[e]; }
        }
        u32x4 kw; kw.x = pk_bf16(kf[0], kf[1]); kw.y = pk_bf16(kf[2], kf[3]); kw.z = pk_bf16(kf[4], kf[5]); kw.w = pk_bf16(kf[6], kf[7]);
        *(u32x4*)(Ks + s * 72 + d0) = kw;
#pragma unroll
        for (int e = 0; e < 8; ++e) Vt[(d0 + e) * 200 + s] = f2bf(vf[e]);
    }
    for (int idx = tid; idx < 1024; idx += 512) {
        const int g = idx >> 8, x = idx & 255;
        biasT[idx] = P.in[22][t5_bucket_n(x - 63) * 16 + kh * 4 + g];
    }
    __syncthreads();
    const int nrows = samp ? 64 : 256;
    if (w * 32 < nrows) {
        const int r = w * 32 + lq;
        int g, t;
        if (!samp) { g = r >> 6; t = r & 63; } else { g = r >> 4; t = r & 15; }
        const int head = kh * 4 + g;
        const size_t qrow = qrow0 + t;
        bf16x8 qf[4];
#pragma unroll
        for (int ks = 0; ks < 4; ++ks) qf[ks] = *(const bf16x8*)(proj + qrow * NIN + OFF_Q + head * 64 + ks * 16 + hh * 8);
        const int kb_lo = samp ? 0 : (nc >= 2 ? 0 : (2 - nc) * 2);
        const int kb_hi = samp ? 5 : 6;
        f32x16 sc[6];
#pragma unroll
        for (int kb = 0; kb < 6; ++kb) {
#pragma unroll
            for (int j = 0; j < 16; ++j) sc[kb][j] = 0.f;
            if (kb >= kb_lo && kb < kb_hi) {
#pragma unroll
                for (int ks = 0; ks < 4; ++ks) {
                    const bf16x8 kf = *(const bf16x8*)(Ks + (kb * 32 + lq) * 72 + ks * 16 + hh * 8);
                    sc[kb] = __builtin_amdgcn_mfma_f32_32x32x16_bf16(kf, qf[ks], sc[kb], 0, 0, 0);
                }
            }
        }
        const float sink = P.in[21][l * 16 + head];
        const float* bt = biasT + g * 256 + 63 + t + 128;
        float mx = sink;
#pragma unroll
        for (int kb = 0; kb < 6; ++kb) {
            if (kb >= kb_lo && kb < kb_hi) {
#pragma unroll
                for (int j = 0; j < 16; ++j) {
                    const int key = kb * 32 + 8 * (j >> 2) + 4 * hh + (j & 3);
                    float lg = sc[kb][j] * 0.125f + bt[-key];
                    if (samp && key >= 144) lg = -1e30f;
                    sc[kb][j] = lg; mx = fmaxf(mx, lg);
                }
            }
        }
        mx = fmaxf(mx, __shfl_xor(mx, 32));
        float sum = 0.f;
#pragma unroll
        for (int kb = 0; kb < 6; ++kb) {
            if (kb >= kb_lo && kb < kb_hi) {
#pragma unroll
                for (int j = 0; j < 16; ++j) { const float p = __expf(sc[kb][j] - mx); sc[kb][j] = p; sum += p; }
            }
        }
        sum += __shfl_xor(sum, 32);
        sum += __expf(sink - mx);
        const float inv = 1.f / sum;
        f32x16 oacc[2];
#pragma unroll
        for (int db = 0; db < 2; ++db)
#pragma unroll
            for (int j = 0; j < 16; ++j) oacc[db][j] = 0.f;
#pragma unroll
        for (int kb = 0; kb < 6; ++kb) {
            if (kb >= kb_lo && kb < kb_hi) {
#pragma unroll
                for (int k2 = 0; k2 < 2; ++k2) {
                    u32x4 pw;
                    pw.x = pk_bf16(sc[kb][8 * k2 + 0], sc[kb][8 * k2 + 1]); pw.y = pk_bf16(sc[kb][8 * k2 + 2], sc[kb][8 * k2 + 3]);
                    pw.z = pk_bf16(sc[kb][8 * k2 + 4], sc[kb][8 * k2 + 5]); pw.w = pk_bf16(sc[kb][8 * k2 + 6], sc[kb][8 * k2 + 7]);
                    bf16x8 pf; __builtin_memcpy(&pf, &pw, 16);
#pragma unroll
                    for (int db = 0; db < 2; ++db) {
                        const u16* vp = Vt + (db * 32 + lq) * 200 + kb * 32 + 16 * k2 + 4 * hh;
                        u32x4 vw; const u32x2 va = *(const u32x2*)vp, vb2 = *(const u32x2*)(vp + 8);
                        vw.x = va.x; vw.y = va.y; vw.z = vb2.x; vw.w = vb2.y;
                        bf16x8 vfr; __builtin_memcpy(&vfr, &vw, 16);
                        oacc[db] = __builtin_amdgcn_mfma_f32_32x32x16_bf16(vfr, pf, oacc[db], 0, 0, 0);
                    }
                }
            }
        }
#pragma unroll
        for (int db = 0; db < 2; ++db)
#pragma unroll
            for (int jq = 0; jq < 4; ++jq) {
                const int d = db * 32 + 8 * jq + 4 * hh;
                u16* gp = proj + qrow * NIN + OFF_GATE + 2048 + head * 64 + d;
                const u32x2 gz = *(const u32x2*)gp;
                u32x2 o;
                o.x = pk_bf16(oacc[db][4 * jq + 0] * inv * lo_bf(gz.x), oacc[db][4 * jq + 1] * inv * hi_bf(gz.x));
                o.y = pk_bf16(oacc[db][4 * jq + 2] * inv * lo_bf(gz.y), oacc[db][4 * jq + 3] * inv * hi_bf(gz.y));
                *(u32x2*)gp = o;
            }
    }
}

template <int l>
__device__ __forceinline__ void layer_body(const Params& P, cg::grid_group& grid, unsigned char* smem) {
    const int G = gridDim.x, bid = blockIdx.x;
    unsigned* ctl = (unsigned*)(P.ws + WS_CTL);
    u16* wtin = (u16*)(P.ws + WS_WTIN); u16* wtbr = (u16*)(P.ws + WS_WTBR); u16* wtout = (u16*)(P.ws + WS_WTOUT);
    u16* hbuf = (u16*)(P.ws + WS_H); u16* proj = (u16*)(P.ws + WS_PROJ);
    LAS unsigned char* lds = (LAS unsigned char*)smem;
    LAS int* slot = (LAS int*)(lds + 131072);
        const u16* wt_l = wtin + (size_t)l * NIN_PAD * 2048;
        EpiIn ein{proj};
        { SchedIn S{hbuf, wt_l, 0, nullptr, slot, G, bid, 0, opaque_tid() == 0}; gemm_phase(lds, 2048, 2048, S, ein); }
        grid.sync();
        for (int t = bid; t < MP / 64; t += G) rwkv_prep_tile<4>(P, l, t * 64, smem);
        for (int t = bid; t < MS / 16; t += G) rwkv_prep_tile<1>(P, l, MP + t * 16, smem);
        grid.sync();
        if (G > 128) {
            if (bid < 64) scan_item(P, l, bid, smem, 0, 192);
            else { SchedIn S{hbuf, wt_l, 1, nullptr, slot, G - 64, bid - 64, 0, false}; gemm_phase(lds, 2048, 2048, S, ein); }
            grid.sync();
            if (bid < 64) scan_item(P, l, bid, smem, 192, 256, true);
            else {
                for (int v = bid; v < 320; v += G - 64) scan_item(P, l, v, smem);
                side_outputs(P, l, G - 64, bid - 64);
                for (int it = bid - 64; it < 1088 + 520; it += G - 64) { if (it < 1088) attn_item(P, l, it, smem); else pool_item(P, l, it - 1088, smem); }
            }
            grid.sync();
            { const int per = (M + G - 1) / G, rb = bid * per; rwkv_post_rows(P, l, rb, (rb + per) < M ? (rb + per) : M); }
        } else {
            for (int v = bid; v < 320; v += G) scan_item(P, l, v, smem);
            __syncthreads();
            { SchedIn S{hbuf, wt_l, 1, ctl + l * 16, slot, G, bid, 0, opaque_tid() == 0}; gemm_phase(lds, 2048, 2048, S, ein); }
            grid.sync();
            side_outputs(P, l, G, bid);
            for (int it = bid; it < 1088 + 520 + 520; it += G) {
                if (it < 1088) attn_item(P, l, it, smem);
                else if (it < 1608) pool_item(P, l, it - 1088, smem);
                else rwkv_post_rows(P, l, (it - 1608) * 32, (it - 1608) * 32 + 32);
            }
        }
        grid.sync();
        { SchedBr S{proj, wtbr + (size_t)l * 3 * 2048 * 1024, G, bid}; EpiBr e{proj, hbuf}; __syncthreads(); gemm_phase(lds, 1024, NIN, S, e); }
        for (int t = bid; t < 256; t += G) branch_small(P, l, t, smem);
        grid.sync();
        { SchedOut S{hbuf, wtout + (size_t)l * 2048 * 2048, G, bid};
          EpiOut e{l == 0 ? P.in[0] : P.out, l == 0 ? P.in[1] : P.out + (size_t)MP * D, P.out}; gemm_phase(lds, 2048, 2048, S, e); }
        for (int t = bid; t < 256; t += G) out_small(P, l, t, smem);
        grid.sync();
        if (l == 0) { rms_rows<true>(P.out, P.out + (size_t)MP * D, P.in[7] + D, hbuf, nullptr); grid.sync(); }
    }

__global__ void __launch_bounds__(512, 2) fwd_megakernel(Params P) {
    extern __shared__ __attribute__((aligned(16))) unsigned char smem[];
    cg::grid_group grid = cg::this_grid();
    const int G = gridDim.x, bid = blockIdx.x;
    unsigned* ctl = (unsigned*)(P.ws + WS_CTL);
    u16* wtin = (u16*)(P.ws + WS_WTIN); u16* wtbr = (u16*)(P.ws + WS_WTBR); u16* wtout = (u16*)(P.ws + WS_WTOUT);
    u16* wtpool = (u16*)(P.ws + WS_WTPOOL); u16* wupt = (u16*)(P.ws + WS_WUPT); u16* aupt = (u16*)(P.ws + WS_AUPT);
    u16* hbuf = (u16*)(P.ws + WS_H); u16* proj = (u16*)(P.ws + WS_PROJ);
    LAS unsigned char* lds = (LAS unsigned char*)smem;
    LAS int* slot = (LAS int*)(lds + 131072);

    if ((threadIdx.x & 63) == 0) ((volatile int*)(smem + 131072 + 256))[__builtin_amdgcn_s_getreg(10244) & 63] = threadIdx.x >> 6;
    __syncthreads();
    if (bid == 0 && opaque_tid() < 64) ctl[opaque_tid()] = 0u;
    {
        int base = 0; float* tile = (float*)smem;
        for (int l = 0; l < 2; ++l) {
            tr_cvt(P.in[8] + (size_t)l * 2048 * NIN, 2048, NIN, wtin + (size_t)l * NIN_PAD * 2048, base, tile);
            for (int b = 0; b < 3; ++b) tr_cvt(P.in[23] + (size_t)(l * 3 + b) * 1024 * 2048, 1024, 2048, wtbr + (size_t)(l * 3 + b) * 2048 * 1024, base, tile);
            tr_cvt(P.in[24] + (size_t)l * 2048 * 2048, 2048, 2048, wtout + (size_t)l * 2048 * 2048, base, tile);
            for (int g = 0; g < 4; ++g) tr_cvt(P.in[9] + (size_t)(l * 4 + g) * 65536, 256, 256, wtpool + (size_t)(l * 4 + g) * 65536, base, tile);
            tr_cvt(P.in[13] + (size_t)l * 64 * 1024, 64, 1024, wupt + (size_t)l * 1024 * 64, base, tile);
            tr_cvt(P.in[15] + (size_t)l * 64 * 1024, 64, 1024, aupt + (size_t)l * 1024 * 64, base, tile);
        }
    }
    rms_rows<true>(P.in[0], P.in[1], P.in[7], hbuf, nullptr);
    grid.sync();

    layer_body<0>(P, grid, smem);
    layer_body<1>(P, grid, smem);
    rms_rows<false>(P.out, P.out + (size_t)MP * D, P.in[25], nullptr, P.out);
}

extern "C" void kernel_launch(void* const* d_in, const int* in_sizes, int n_in, void* d_out, int out_size, void* d_ws, size_t ws_size, hipStream_t stream) {
    static int grid_blocks = 0;
    if (grid_blocks == 0) {
        if (n_in != 26 || (size_t)out_size != O_END || ws_size < WS_END) {
            fprintf(stderr, "kernel_launch: unexpected shapes: n_in %d out %d ws %zu (need %zu)\n", n_in, out_size, ws_size, (size_t)WS_END); grid_blocks = -1; return; }
        int dev = 0, cus = 0, per_cu = 0;
        hipGetDevice(&dev);
        hipDeviceGetAttribute(&cus, hipDeviceAttributeMultiprocessorCount, dev);
        hipFuncSetAttribute((const void*)fwd_megakernel, hipFuncAttributeMaxDynamicSharedMemorySize, LDS_BYTES);
        hipOccupancyMaxActiveBlocksPerMultiprocessor(&per_cu, (const void*)fwd_megakernel, 512, LDS_BYTES);
        if (per_cu < 1) per_cu = 1;
        grid_blocks = cus * per_cu;
        if (grid_blocks > 256) grid_blocks = 256;
    }
    if (grid_blocks < 0) return;
    Params p{};
    for (int i = 0; i < 26; ++i) p.in[i] = (const float*)d_in[i];
    p.out = (float*)d_out; p.ws = (unsigned char*)d_ws;
    void* args[] = {&p};
    hipError_t e = hipLaunchCooperativeKernel((const void*)fwd_megakernel, dim3(grid_blocks), dim3(512), args, LDS_BYTES, stream);
    if (e != hipSuccess) fprintf(stderr, "cooperative launch failed: %s (grid %d)\n", hipGetErrorString(e), grid_blocks);
}
```

```cpp
#include <hip/hip_runtime.h>
#include <hip/hip_cooperative_groups.h>
#include <cstdio>
#include <type_traits>
namespace cg = cooperative_groups;

#define LAS __attribute__((address_space(3)))
typedef unsigned short u16;
typedef short bf16x8 __attribute__((ext_vector_type(8)));
typedef float f32x4 __attribute__((ext_vector_type(4)));
typedef float f32x16 __attribute__((ext_vector_type(16)));
typedef unsigned u32x4 __attribute__((ext_vector_type(4)));
typedef unsigned u32x2 __attribute__((ext_vector_type(2)));

constexpr int D = 2048, MP = 16384, MS = 256, M = MP + MS;
constexpr int NIN = 14976, NIN_PAD = 15104;
constexpr int OFF_POOL = 0, OFF_SHIFT = 1024, OFF_Q = 4224, OFF_K = 5248, OFF_V = 5504, OFF_GATE = 5760, OFF_MERGE = 8832;
constexpr int SHIFT_W = 3200;
constexpr size_t O_YP = 0, O_YS = O_YP + (size_t)MP * D, O_KP = O_YS + (size_t)MS * D, O_VP = O_KP + 2 * 4 * 128 * 256, O_KS = O_VP + 2 * 4 * 128 * 256,
                 O_VS = O_KS + 2 * 16 * 16 * 256, O_RP = O_VS + 2 * 16 * 16 * 256, O_RS = O_RP + 2 * 4 * 16 * 4096, O_SHP = O_RS + 2 * 16 * 16 * 4096,
                 O_SHS = O_SHP + 2 * 4 * 3200, O_PLP = O_SHS + 2 * 16 * 3200, O_PLS = O_PLP + 2 * 4 * 15 * 1024, O_END = O_PLS + 2 * 16 * 15 * 1024;
constexpr size_t WS_BAR = 0, WS_CTL = 16384, WS_WTIN = 20480, WS_WTBR = WS_WTIN + (size_t)2 * NIN_PAD * 2048 * 2, WS_WTOUT = WS_WTBR + (size_t)2 * 3 * 2048 * 1024 * 2,
                 WS_WTPOOL = WS_WTOUT + (size_t)2 * 2048 * 2048 * 2, WS_WUPT = WS_WTPOOL + (size_t)2 * 4 * 256 * 256 * 2, WS_AUPT = WS_WUPT + (size_t)2 * 1024 * 64 * 2,
                 WS_H = WS_AUPT + (size_t)2 * 1024 * 64 * 2, WS_PROJ = WS_H + (size_t)M * 2048 * 2, WS_DEC = WS_PROJ + (size_t)M * NIN * 2,
                 WS_AA = WS_DEC + (size_t)M * 1024 * 4, WS_YRAW = WS_AA + (size_t)M * 1024 * 4, WS_END = WS_YRAW + (size_t)M * 1024 * 4;
constexpr int LDS_BYTES = 131072 + 512;

struct Params { const float* in[26]; float* out; unsigned char* ws; };

__device__ __forceinline__ unsigned pk_bf16(float lo, float hi) { unsigned r; asm("v_cvt_pk_bf16_f32 %0, %1, %2" : "=v"(r) : "v"(lo), "v"(hi)); return r; }
__device__ __forceinline__ u16 f2bf(float x) { return (u16)(pk_bf16(x, 0.f) & 0xffffu); }
__device__ __forceinline__ float bf2f(u16 x) { return __uint_as_float(((unsigned)x) << 16); }
__device__ __forceinline__ float lo_bf(unsigned w) { return __uint_as_float(w << 16); }
__device__ __forceinline__ float hi_bf(unsigned w) { return __uint_as_float(w & 0xffff0000u); }
__device__ __forceinline__ float sigm(float x) { return __builtin_amdgcn_rcpf(1.f + __expf(-x)); }
__device__ __forceinline__ int opaque_tid() {
    extern __shared__ __attribute__((aligned(16))) unsigned char smem_all[];
    const int key = __builtin_amdgcn_s_getreg(10244) & 63;
    int wv = ((const volatile int*)(smem_all + 131072 + 256))[key];
    wv = __builtin_amdgcn_readfirstlane(wv);
    int t = (wv << 6) | (int)__builtin_amdgcn_mbcnt_hi(~0u, __builtin_amdgcn_mbcnt_lo(~0u, 0u));
    asm volatile("" : "+v"(t)); return t; }
template <int CTRL> __device__ __forceinline__ float dppf(float x) { return __int_as_float(__builtin_amdgcn_update_dpp(0, __float_as_int(x), CTRL, 0xF, 0xF, true)); }
__device__ __forceinline__ float wave_sum(float x) {
    x += dppf<0xB1>(x); x += dppf<0x4E>(x); x += dppf<0x141>(x); x += dppf<0x140>(x);
    x += __int_as_float(__builtin_amdgcn_update_dpp(0, __float_as_int(x), 0x142, 0xA, 0xF, false));
    x += __int_as_float(__builtin_amdgcn_update_dpp(0, __float_as_int(x), 0x143, 0xC, 0xF, false));
    return __int_as_float(__builtin_amdgcn_readlane(__float_as_int(x), 63));
}
__device__ __forceinline__ float red8(float x) { x += dppf<0xB1>(x); x += dppf<0x4E>(x); x += dppf<0x141>(x); return x; }
__device__ __forceinline__ void unpack8(u32x4 w, float* f) {
    f[0] = lo_bf(w.x); f[1] = hi_bf(w.x); f[2] = lo_bf(w.y); f[3] = hi_bf(w.y); f[4] = lo_bf(w.z); f[5] = hi_bf(w.z); f[6] = lo_bf(w.w); f[7] = hi_bf(w.w);
}

__device__ __forceinline__ void tr_cvt(const float* __restrict__ src, int K, int N, u16* __restrict__ dst, int& base, float* tile) {
    const int tid = opaque_tid();
    const int tn = N >> 7, tk = K >> 6, nt = tn * tk;
    const int G = gridDim.x;
    const int start = (int)((blockIdx.x + G - (base % G)) % G);
    for (int t = start; t < nt; t += G) {
        const int k0 = (t / tn) << 6, n0 = (t % tn) << 7;
        __syncthreads();
        {
            const int r = tid >> 5, c = (tid & 31) << 2;
            f32x4 v[4];
#pragma unroll
            for (int q = 0; q < 4; ++q) v[q] = *(const f32x4*)(src + (size_t)(k0 + r + q * 16) * N + n0 + c);
#pragma unroll
            for (int q = 0; q < 4; ++q)
#pragma unroll
                for (int e = 0; e < 4; ++e) tile[(r + q * 16) * 129 + c + e] = v[q][e];
        }
        __syncthreads();
        {
            const int n = tid >> 2, k16 = (tid & 3) << 4;
            float v[16];
#pragma unroll
            for (int e = 0; e < 16; ++e) v[e] = tile[(k16 + e) * 129 + n];
            u32x4 w0, w1;
            w0.x = pk_bf16(v[0], v[1]); w0.y = pk_bf16(v[2], v[3]); w0.z = pk_bf16(v[4], v[5]); w0.w = pk_bf16(v[6], v[7]);
            w1.x = pk_bf16(v[8], v[9]); w1.y = pk_bf16(v[10], v[11]); w1.z = pk_bf16(v[12], v[13]); w1.w = pk_bf16(v[14], v[15]);
            u16* dp = dst + (size_t)(n0 + n) * K + k0 + k16;
            *(u32x4*)dp = w0; *(u32x4*)(dp + 8) = w1;
        }
    }
    base += nt;
}

template <bool TO_BF16>
__device__ __forceinline__ void rms_rows(const float* xp, const float* xs, const float* __restrict__ g, u16* h, float* yo) {
    const int tid_ = opaque_tid(); const int wid = tid_ >> 6, lane = tid_ & 63;
    const int stride = gridDim.x * 8;
    for (int row0 = blockIdx.x * 8 + wid; row0 < M; row0 += 2 * stride) {
        const int rowB = row0 + stride; const bool hasB = rowB < M;
        const float* srcA = row0 < MP ? xp + (size_t)row0 * D : xs + (size_t)(row0 - MP) * D;
        const float* srcB = hasB ? (rowB < MP ? xp + (size_t)rowB * D : xs + (size_t)(rowB - MP) * D) : srcA;
        f32x4 va[8], vb[8]; float sa = 0.f, sb = 0.f;
#pragma unroll
        for (int i = 0; i < 8; ++i) { va[i] = *(const f32x4*)(srcA + i * 256 + lane * 4); vb[i] = *(const f32x4*)(srcB + i * 256 + lane * 4); }
#pragma unroll
        for (int i = 0; i < 8; ++i) { sa += va[i][0] * va[i][0] + va[i][1] * va[i][1] + va[i][2] * va[i][2] + va[i][3] * va[i][3];
                                      sb += vb[i][0] * vb[i][0] + vb[i][1] * vb[i][1] + vb[i][2] * vb[i][2] + vb[i][3] * vb[i][3]; }
        sa = wave_sum(sa); sb = wave_sum(sb);
        const float ra = rsqrtf(sa * (1.0f / D) + 1e-6f), rb = rsqrtf(sb * (1.0f / D) + 1e-6f);
#pragma unroll
        for (int i = 0; i < 8; ++i) {
            const f32x4 gg = *(const f32x4*)(g + i * 256 + lane * 4);
            f32x4 oa, ob;
#pragma unroll
            for (int e = 0; e < 4; ++e) { oa[e] = va[i][e] * ra * gg[e]; ob[e] = vb[i][e] * rb * gg[e]; }
            if (TO_BF16) {
                u32x2 w; w.x = pk_bf16(oa[0], oa[1]); w.y = pk_bf16(oa[2], oa[3]); *(u32x2*)(h + (size_t)row0 * D + i * 256 + lane * 4) = w;
                if (hasB) { w.x = pk_bf16(ob[0], ob[1]); w.y = pk_bf16(ob[2], ob[3]); *(u32x2*)(h + (size_t)rowB * D + i * 256 + lane * 4) = w; }
            } else {
                *(f32x4*)(yo + (size_t)row0 * D + i * 256 + lane * 4) = oa;
                if (hasB) *(f32x4*)(yo + (size_t)rowB * D + i * 256 + lane * 4) = ob;
            }
        }
    }
}

constexpr int BM = 256, BK = 64, HALF = 128, HTB = HALF * BK * 2;
__device__ __forceinline__ int lds_byte(int r, int c) { const int st = (r >> 4) * 2 + (c >> 5), rr = r & 15, cc = c & 31, ob = rr * 64 + cc * 2; return st * 1024 + (ob ^ (((ob >> 9) & 1) << 5)); }
__device__ __forceinline__ void stage_rc(int b, int& R, int& C) { const int st = b / 1024, sb = b % 1024, swz = sb ^ (((sb >> 9) & 1) << 5); R = (st >> 1) * 16 + swz / 64; C = (st & 1) * 32 + (swz % 64) / 2; }
__device__ __forceinline__ int perm32(int rho) { const int n = rho >> 4, i = rho & 15; return 8 * (i >> 2) + 4 * n + (i & 3); }
struct Unit { int pm, pn, z; };

template <class Epi, class Sched>
__device__ __forceinline__ void gemm_phase(LAS unsigned char* lds, const int K, const int lda, Sched& S, const Epi& E) {
    const int tid = opaque_tid(), wid = __builtin_amdgcn_readfirstlane(tid >> 6), lane = tid & 63, wr = wid >> 2, wc = wid & 3, fr = lane & 15, fq = lane >> 4;
    const int nt = K / BK;
    unsigned voffA[2], voffB[2];
#pragma unroll
    for (int i = 0; i < 2; ++i) { int R, C; stage_rc(tid * 16 + i * 8192, R, C); const int Rb = (R & ~31) + perm32(R & 31);
        voffA[i] = (unsigned)(R * lda + C) * 2u; voffB[i] = (unsigned)(Rb * K + C) * 2u; }
    const size_t kstep = (size_t)(BK * 2);
    const size_t hstepA = (size_t)HALF * lda * 2, hstepB = (size_t)HALF * K * 2;
    const unsigned ldsw = (unsigned)wid * 1024u;
    const int aoff = lds_byte(wr * 64 + fr, fq * 8), boff = lds_byte(wc * 32 + fr, fq * 8);
#define PG8_SA(b, h) (((b) * 2 + (h)) * HTB)
#define PG8_SB(b, h) ((4 + (b) * 2 + (h)) * HTB)
#define PG8_STAGE(bufoff, gbase, voff) do { _Pragma("unroll") for (int _i = 0; _i < 2; ++_i) \
        __builtin_amdgcn_global_load_lds((const unsigned*)((const char*)(gbase) + (voff)[_i]), (LAS unsigned*)(lds + (bufoff) + ldsw + _i * 8192), 16, 0, 0); } while (0)
#define PG8_LDA(dst, b, h) do { _Pragma("unroll") for (int m = 0; m < 4; ++m) _Pragma("unroll") for (int k = 0; k < 2; ++k) dst[m][k] = *(const LAS bf16x8*)(lds + PG8_SA(b, h) + aoff + m * 2048 + k * 1024); } while (0)
#define PG8_LDB(dst, b, h) do { _Pragma("unroll") for (int n = 0; n < 2; ++n) _Pragma("unroll") for (int k = 0; k < 2; ++k) dst[n][k] = *(const LAS bf16x8*)(lds + PG8_SB(b, h) + boff + n * 2048 + k * 1024); } while (0)
#define PG8_MMA(ai, bj, At, Bt) do { __builtin_amdgcn_s_setprio(1); _Pragma("unroll") for (int m = 0; m < 4; ++m) _Pragma("unroll") for (int n = 0; n < 2; ++n) _Pragma("unroll") for (int k = 0; k < 2; ++k) \
        acc[ai][bj][m][n] = __builtin_amdgcn_mfma_f32_16x16x32_bf16(Bt[n][k], At[m][k], acc[ai][bj][m][n], 0, 0, 0); __builtin_amdgcn_s_setprio(0); } while (0)
#define PG8_WAIT_V(n) asm volatile("s_waitcnt vmcnt(" #n ")" ::: "memory")
#define PG8_WAIT_L(n) asm volatile("s_waitcnt lgkmcnt(" #n ")" ::: "memory")
#define PG8_BAR __builtin_amdgcn_s_barrier()
#define PG8_SCHED __builtin_amdgcn_sched_barrier(0)
    Unit cur, nxt; int ui = 0;
    if (!S.next(0, cur)) return;
    f32x4 acc[2][2][4][2];
#pragma unroll
    for (int a = 0; a < 2; ++a)
#pragma unroll
        for (int b = 0; b < 2; ++b)
#pragma unroll
            for (int m = 0; m < 4; ++m)
#pragma unroll
                for (int n = 0; n < 2; ++n) acc[a][b][m][n] = (f32x4){0.f, 0.f, 0.f, 0.f};
    bf16x8 At[4][2], B0[2][2], B1[2][2];
    const char* cA = S.aptr(cur); const char* cB = S.bptr(cur);
    PG8_STAGE(PG8_SB(0, 0), cB, voffB); PG8_STAGE(PG8_SA(0, 0), cA, voffA); PG8_STAGE(PG8_SB(0, 1), cB + hstepB, voffB); PG8_STAGE(PG8_SA(0, 1), cA + hstepA, voffA);
    if (wr == 1) PG8_BAR;
    PG8_WAIT_V(4); PG8_BAR;
    PG8_STAGE(PG8_SB(1, 0), cB + kstep, voffB); PG8_STAGE(PG8_SA(1, 0), cA + kstep, voffA); PG8_STAGE(PG8_SB(1, 1), cB + hstepB + kstep, voffB);
    PG8_WAIT_V(6); PG8_BAR;
    for (;;) {
        const bool has_next = S.next(ui + 1, nxt);
        const char* nA = has_next ? S.aptr(nxt) : cA; const char* nB = has_next ? S.bptr(nxt) : cB;
        for (int t = 0; t < nt; t += 2) {
            const bool last = (t == nt - 2);
            const char* a1 = cA + (size_t)(t + 1) * kstep;
            const char* a2 = last ? nA : cA + (size_t)(t + 2) * kstep; const char* b2 = last ? nB : cB + (size_t)(t + 2) * kstep;
            const char* a3 = a2 + kstep; const char* b3 = b2 + kstep;
            PG8_LDB(B0, 0, 0); PG8_SCHED; PG8_LDA(At, 0, 0); PG8_STAGE(PG8_SA(1, 1), a1 + hstepA, voffA);
            PG8_WAIT_L(8); PG8_BAR; PG8_WAIT_L(0); PG8_MMA(0, 0, At, B0); PG8_BAR; PG8_SCHED;
            PG8_LDB(B1, 0, 1); PG8_STAGE(PG8_SB(0, 0), b2, voffB);
            PG8_BAR; PG8_WAIT_L(0); PG8_MMA(0, 1, At, B1); PG8_BAR;
            PG8_LDA(At, 0, 1); PG8_STAGE(PG8_SA(0, 0), a2, voffA);
            PG8_BAR; PG8_WAIT_L(0); PG8_MMA(1, 0, At, B0); PG8_BAR; PG8_SCHED;
            PG8_STAGE(PG8_SB(0, 1), b2 + hstepB, voffB);
            PG8_WAIT_V(6); PG8_BAR; PG8_MMA(1, 1, At, B1); PG8_BAR;
            PG8_LDB(B0, 1, 0); PG8_SCHED; PG8_LDA(At, 1, 0); PG8_STAGE(PG8_SA(0, 1), a2 + hstepA, voffA);
            PG8_WAIT_L(8); PG8_BAR; PG8_WAIT_L(0); PG8_MMA(0, 0, At, B0); PG8_BAR; PG8_SCHED;
            PG8_LDB(B1, 1, 1); PG8_STAGE(PG8_SB(1, 0), b3, voffB);
            PG8_BAR; PG8_WAIT_L(0); PG8_MMA(0, 1, At, B1); PG8_BAR;
            PG8_LDA(At, 1, 1); PG8_STAGE(PG8_SA(1, 0), a3, voffA);
            PG8_BAR; PG8_WAIT_L(0); PG8_MMA(1, 0, At, B0); PG8_BAR; PG8_SCHED;
            PG8_STAGE(PG8_SB(1, 1), b3 + hstepB, voffB);
            PG8_WAIT_V(6); PG8_BAR; PG8_MMA(1, 1, At, B1); PG8_BAR;
        }
        E(acc, cur, wr, wc, fr, fq);
        if (!has_next) break;
        if (E.zero_after(cur))
#pragma unroll
        for (int a = 0; a < 2; ++a)
#pragma unroll
            for (int b = 0; b < 2; ++b)
#pragma unroll
                for (int m = 0; m < 4; ++m)
#pragma unroll
                    for (int n = 0; n < 2; ++n) acc[a][b][m][n] = (f32x4){0.f, 0.f, 0.f, 0.f};
        cur = nxt; cA = nA; cB = nB; ++ui;
    }
    PG8_WAIT_V(0);
    if (wr == 0) PG8_BAR;
    PG8_BAR;
#undef PG8_SA
#undef PG8_SB
#undef PG8_STAGE
#undef PG8_LDA
#undef PG8_LDB
#undef PG8_MMA
#undef PG8_WAIT_V
#undef PG8_WAIT_L
#undef PG8_BAR
#undef PG8_SCHED
}

__device__ __forceinline__ int xcd_remap(int L, int nwg) {
    const int q = nwg >> 3, r = nwg & 7, xcd = L & 7, off = L >> 3;
    return (xcd < r ? xcd * (q + 1) : r * (q + 1) + (xcd - r) * q) + off;
}
__device__ __forceinline__ void map_tile(int L, int nq, int nM, int& pm, int& q) {
    const int nig = 8 * nq, gid = L / nig, fm = gid * 8, gsz = (nM - fm) < 8 ? (nM - fm) : 8;
    pm = fm + ((L % nig) % gsz); q = (L % nig) / gsz;
}
struct SchedIn {
    const u16* A; const u16* Bt; int set; unsigned* ctr; LAS int* slot; int G, c; int steal; bool t0;
    __device__ __forceinline__ bool next(int i, Unit& u) {
        const int nq = set == 0 ? 18 : 41, nwg = 65 * nq;
        int L;
        if (ctr) {
            if (t0) {
                const int q8 = nwg >> 3, r8 = nwg & 7;
                int res = nwg;
                while (steal < 8) {
                    const int x = (c + steal) & 7;
                    const int cnt = q8 + (x < r8 ? 1 : 0), base = x < r8 ? x * (q8 + 1) : r8 * (q8 + 1) + (x - r8) * q8;
                    const int v = (int)atomicAdd(ctr + x, 1u);
                    if (v < cnt) { res = base + v; break; }
                    ++steal;
                }
                slot[i & 1] = res; asm volatile("s_waitcnt lgkmcnt(0)" ::: "memory");
            }
            __builtin_amdgcn_s_barrier();
            asm volatile("" ::: "memory");
            L = slot[i & 1];
            if (L >= nwg) return false;
        } else { L = i * G + c; if (L >= nwg) return false; L = xcd_remap(L, nwg); }
        int q; map_tile(L, nq, 65, u.pm, q);
        if (set == 0) u.pn = q < 13 ? 4 + q : 26 + (q - 13);
        else u.pn = q < 4 ? q : (q < 13 ? 17 + (q - 4) : 31 + (q - 13));
        u.z = 0; return true;
    }
    __device__ __forceinline__ const char* aptr(const Unit& u) const { return (const char*)(A + (size_t)u.pm * 256 * 2048); }
    __device__ __forceinline__ const char* bptr(const Unit& u) const { return (const char*)(Bt + (size_t)u.pn * 256 * 2048); }
};
struct SchedBr {
    const u16* A; const u16* Bt; int G, c;
    __device__ __forceinline__ bool next(int i, Unit& u) {
        int L = (i / 3) * G + c; if (L >= 64 * 8) return false;
        L = xcd_remap(L, 64 * 8);
        map_tile(L, 8, 64, u.pm, u.pn); u.z = i % 3; return true;
    }
    __device__ __forceinline__ const char* aptr(const Unit& u) const { return (const char*)(A + (size_t)u.pm * 256 * NIN + OFF_GATE + u.z * 1024); }
    __device__ __forceinline__ const char* bptr(const Unit& u) const { return (const char*)(Bt + (size_t)u.z * 2048 * 1024 + (size_t)u.pn * 256 * 1024); }
};
struct SchedOut {
    const u16* A; const u16* Bt; int G, c;
    __device__ __forceinline__ bool next(int i, Unit& u) {
        int L = i * G + c; if (L >= 64 * 8) return false;
        L = xcd_remap(L, 64 * 8);
        map_tile(L, 8, 64, u.pm, u.pn); u.z = 0; return true;
    }
    __device__ __forceinline__ const char* aptr(const Unit& u) const { return (const char*)(A + (size_t)u.pm * 256 * 2048); }
    __device__ __forceinline__ const char* bptr(const Unit& u) const { return (const char*)(Bt + (size_t)u.pn * 256 * 2048); }
};

struct EpiIn {
    u16* proj;
    __device__ __forceinline__ bool zero_after(const Unit&) const { return true; }
    __device__ __forceinline__ void operator()(f32x4 (&acc)[2][2][4][2], const Unit& u, int wr, int wc, int fr, int fq) const {
#pragma unroll
        for (int bj = 0; bj < 2; ++bj) {
            const int colb = u.pn * 256 + bj * 128;
            if (colb >= NIN) continue;
            const int act = colb >= OFF_MERGE ? 2 : (colb >= OFF_GATE ? 1 : 0);
            u16* pb = proj + (size_t)(u.pm * 256 + wr * 64 + fr) * NIN + colb + wc * 32 + 8 * fq;
#pragma unroll
            for (int ai = 0; ai < 2; ++ai)
#pragma unroll
                for (int m = 0; m < 4; ++m) {
                    f32x4 v0 = acc[ai][bj][m][0], v1 = acc[ai][bj][m][1];
                    if (act == 1) {
#pragma unroll
                        for (int j = 0; j < 4; ++j) { v0[j] = v0[j] * sigm(v0[j]); v1[j] = v1[j] * sigm(v1[j]); }
                    } else if (act == 2) {
#pragma unroll
                        for (int j = 0; j < 4; ++j) { v0[j] = sigm(v0[j]); v1[j] = sigm(v1[j]); }
                    }
                    u32x4 w; w.x = pk_bf16(v0[0], v0[1]); w.y = pk_bf16(v0[2], v0[3]); w.z = pk_bf16(v1[0], v1[1]); w.w = pk_bf16(v1[2], v1[3]);
                    *(u32x4*)(pb + (size_t)(ai * 128 + m * 16) * NIN) = w;
                }
        }
    }
};
__device__ __forceinline__ void side_outputs(const Params& P, int l, int nblk, int blk) {
    const u16* proj = (const u16*)(P.ws + WS_PROJ);
    float* out = P.out;
    const int nthr = nblk * 512, gt = blk * 512 + opaque_tid();
    for (int i = gt; i < 4 * 15 * 1024; i += nthr) { const int c = i & 1023, j = (i >> 10) % 15, b = i / (15 * 1024);
        out[O_PLP + (size_t)l * 4 * 15 * 1024 + i] = bf2f(proj[((size_t)b * 4096 + 4081 + j) * NIN + c]); }
    for (int i = gt; i < 16 * 15 * 1024; i += nthr) { const int c = i & 1023, j = (i >> 10) % 15, b = i / (15 * 1024);
        out[O_PLS + (size_t)l * 16 * 15 * 1024 + i] = bf2f(proj[((size_t)MP + b * 16 + 1 + j) * NIN + c]); }
    for (int i = gt; i < 4 * SHIFT_W; i += nthr) { const int c = i % SHIFT_W, b = i / SHIFT_W;
        out[O_SHP + (size_t)l * 4 * SHIFT_W + i] = bf2f(proj[((size_t)b * 4096 + 4095) * NIN + OFF_SHIFT + c]); }
    for (int i = gt; i < 16 * SHIFT_W; i += nthr) { const int c = i % SHIFT_W, b = i / SHIFT_W;
        out[O_SHS + (size_t)l * 16 * SHIFT_W + i] = bf2f(proj[((size_t)MP + b * 16 + 15) * NIN + OFF_SHIFT + c]); }
    for (int i = gt; i < 4 * 128 * 256; i += nthr) { const int c = i & 255, t = (i >> 8) & 127, b = i >> 15;
        const size_t r = ((size_t)b * 4096 + 3968 + t) * NIN;
        out[O_KP + (size_t)l * 4 * 128 * 256 + i] = bf2f(proj[r + OFF_K + c]); out[O_VP + (size_t)l * 4 * 128 * 256 + i] = bf2f(proj[r + OFF_V + c]); }
    for (int i = gt; i < 16 * 16 * 256; i += nthr) { const int c = i & 255, t = (i >> 8) & 15, b = i >> 12;
        const size_t r = ((size_t)MP + b * 16 + t) * NIN;
        out[O_KS + (size_t)l * 16 * 16 * 256 + i] = bf2f(proj[r + OFF_K + c]); out[O_VS + (size_t)l * 16 * 16 * 256 + i] = bf2f(proj[r + OFF_V + c]); }
}
struct EpiBr {
    const u16* proj; u16* merged;
    __device__ __forceinline__ bool zero_after(const Unit& u) const { return u.z == 2; }
    __device__ __forceinline__ void operator()(f32x4 (&acc)[2][2][4][2], const Unit& u, int wr, int wc, int fr, int fq) const {
        const int b = u.z;
        const u16* gbase = proj + (size_t)(u.pm * 256 + wr * 64 + fr) * NIN + OFF_MERGE + b * 2048 + u.pn * 256 + wc * 32 + 8 * fq;
        u16* mbase = merged + (size_t)(u.pm * 256 + wr * 64 + fr) * 2048 + u.pn * 256 + wc * 32 + 8 * fq;
#pragma unroll
        for (int ai = 0; ai < 2; ++ai) {
            u32x4 g[4][2], gn[4][2];
#pragma unroll
            for (int m = 0; m < 4; ++m)
#pragma unroll
                for (int bj = 0; bj < 2; ++bj) {
                    const u16* gp = gbase + (size_t)(ai * 128 + m * 16) * NIN + bj * 128;
                    g[m][bj] = *(const u32x4*)gp;
                    if (b < 2) gn[m][bj] = *(const u32x4*)(gp + 2048);
                }
#pragma unroll
            for (int m = 0; m < 4; ++m)
#pragma unroll
                for (int bj = 0; bj < 2; ++bj) {
                    float gf[8]; unpack8(g[m][bj], gf);
                    if (b < 2) {
                        float gd[8]; unpack8(gn[m][bj], gd);
#pragma unroll
                        for (int j = 0; j < 8; ++j) gf[j] = fmaxf(gf[j], 1e-20f) * __builtin_amdgcn_rcpf(fmaxf(gd[j], 1e-20f));
                    } else {
#pragma unroll
                        for (int j = 0; j < 8; ++j) gf[j] = fmaxf(gf[j], 1e-20f);
                    }
#pragma unroll
                    for (int j = 0; j < 4; ++j) { acc[ai][bj][m][0][j] *= gf[j]; acc[ai][bj][m][1][j] *= gf[4 + j]; }
                    if (b == 2) {
                        const f32x4 v0 = acc[ai][bj][m][0], v1 = acc[ai][bj][m][1];
                        u32x4 w; w.x = pk_bf16(v0[0], v0[1]); w.y = pk_bf16(v0[2], v0[3]); w.z = pk_bf16(v1[0], v1[1]); w.w = pk_bf16(v1[2], v1[3]);
                        *(u32x4*)(mbase + (size_t)(ai * 128 + m * 16) * 2048 + bj * 128) = w;
                    }
                }
        }
    }
};
struct EpiOut {
    const float* xp; const float* xs; float* out;
    __device__ __forceinline__ bool zero_after(const Unit&) const { return true; }
    __device__ __forceinline__ void operator()(f32x4 (&acc)[2][2][4][2], const Unit& u, int wr, int wc, int fr, int fq) const {
        const int r0 = u.pm * 256 + wr * 64 + fr, c0 = u.pn * 256 + wc * 32 + 8 * fq;
        const float* src = (r0 < MP ? xp + (size_t)r0 * D : xs + (size_t)(r0 - MP) * D) + c0;
        float* dst = out + (size_t)r0 * D + c0;
#pragma unroll
        for (int ai = 0; ai < 2; ++ai) {
            f32x4 x[4][2][2];
#pragma unroll
            for (int m = 0; m < 4; ++m)
#pragma unroll
                for (int bj = 0; bj < 2; ++bj) {
                    const float* sp = src + (size_t)(ai * 128 + m * 16) * D + bj * 128;
                    x[m][bj][0] = *(const f32x4*)sp; x[m][bj][1] = *(const f32x4*)(sp + 4);
                }
#pragma unroll
            for (int m = 0; m < 4; ++m)
#pragma unroll
                for (int bj = 0; bj < 2; ++bj) {
                    float* dp = dst + (size_t)(ai * 128 + m * 16) * D + bj * 128;
                    *(f32x4*)dp = x[m][bj][0] + acc[ai][bj][m][0];
                    *(f32x4*)(dp + 4) = x[m][bj][1] + acc[ai][bj][m][1];
                }
        }
    }
};

template <int K>
__device__ __forceinline__ f32x4 small_pass(const u16* A, int lda, const u16* Bt, unsigned char* smem) {
    const int tid = opaque_tid(), w = tid >> 6, lane = tid & 63, fr = lane & 15, fq = lane >> 4;
    float* red = (float*)smem;
    constexpr int kp = K >> 3; const int k0 = w * kp;
    f32x4 acc[2][4];
#pragma unroll
    for (int a = 0; a < 2; ++a)
#pragma unroll
        for (int b = 0; b < 4; ++b) acc[a][b] = (f32x4){0.f, 0.f, 0.f, 0.f};
#pragma unroll
    for (int ks = 0; ks < (kp >> 5); ++ks) {
        const int kk = k0 + ks * 32 + fq * 8;
        bf16x8 af[2], bfr[4];
#pragma unroll
        for (int mb = 0; mb < 2; ++mb) af[mb] = *(const bf16x8*)(A + (size_t)(mb * 16 + fr) * lda + kk);
#pragma unroll
        for (int nb = 0; nb < 4; ++nb) bfr[nb] = *(const bf16x8*)(Bt + (size_t)(nb * 16 + fr) * K + kk);
#pragma unroll
        for (int mb = 0; mb < 2; ++mb)
#pragma unroll
            for (int nb = 0; nb < 4; ++nb) acc[mb][nb] = __builtin_amdgcn_mfma_f32_16x16x32_bf16(bfr[nb], af[mb], acc[mb][nb], 0, 0, 0);
    }
    __syncthreads();
#pragma unroll
    for (int mb = 0; mb < 2; ++mb)
#pragma unroll
        for (int nb = 0; nb < 4; ++nb) *(f32x4*)(red + w * 2048 + (mb * 16 + fr) * 64 + nb * 16 + fq * 4) = acc[mb][nb];
    __syncthreads();
    f32x4 s = {0.f, 0.f, 0.f, 0.f};
#pragma unroll
    for (int ww = 0; ww < 8; ++ww) s += *(const f32x4*)(red + ww * 2048 + tid * 4);
    return s;
}
__device__ __forceinline__ void branch_small(const Params& P, int l, int tile, unsigned char* smem) {
    const int tid = opaque_tid();
    const int R0 = MP + (tile & 7) * 32, N0 = (tile >> 3) * 64;
    const u16* proj = (const u16*)(P.ws + WS_PROJ);
    const u16* wtbr = (const u16*)(P.ws + WS_WTBR) + (size_t)l * 3 * 2048 * 1024;
    const int row = R0 + (tid >> 4), col = N0 + (tid & 15) * 4;
    f32x4 tot = {0.f, 0.f, 0.f, 0.f};
#pragma unroll 1
    for (int z = 0; z < 3; ++z) {
        const f32x4 s = small_pass<1024>(proj + (size_t)R0 * NIN + OFF_GATE + z * 1024, NIN, wtbr + (size_t)z * 2048 * 1024 + (size_t)N0 * 1024, smem);
        const u32x2 g = *(const u32x2*)(proj + (size_t)row * NIN + OFF_MERGE + z * 2048 + col);
        tot[0] += lo_bf(g.x) * s[0]; tot[1] += hi_bf(g.x) * s[1]; tot[2] += lo_bf(g.y) * s[2]; tot[3] += hi_bf(g.y) * s[3];
    }
    u32x2 o; o.x = pk_bf16(tot[0], tot[1]); o.y = pk_bf16(tot[2], tot[3]);
    *(u32x2*)((u16*)(P.ws + WS_H) + (size_t)row * 2048 + col) = o;
}
__device__ __forceinline__ void out_small(const Params& P, int l, int tile, unsigned char* smem) {
    const int tid = opaque_tid();
    const int R0 = MP + (tile & 7) * 32, N0 = (tile >> 3) * 64;
    const u16* merged = (const u16*)(P.ws + WS_H);
    const u16* wtout = (const u16*)(P.ws + WS_WTOUT) + (size_t)l * 2048 * 2048;
    const int row = R0 + (tid >> 4), col = N0 + (tid & 15) * 4;
    const f32x4 s = small_pass<2048>(merged + (size_t)R0 * 2048, 2048, wtout + (size_t)N0 * 2048, smem);
    const float* src = l == 0 ? P.in[1] + (size_t)(row - MP) * D + col : P.out + (size_t)row * D + col;
    const f32x4 x = *(const f32x4*)src;
    *(f32x4*)(P.out + (size_t)row * D + col) = x + s;
}

template <int NMB>
__device__ __forceinline__ void rwkv_prep_tile(const Params& P, int l, int Rbase, unsigned char* smem) {
    const int tid = opaque_tid(), w = tid >> 6, lane = tid & 63, fr = lane & 15, fq = lane >> 4;
    u16* A1 = (u16*)smem; u16* A2 = A1 + 64 * 72;
    const u16* proj = (const u16*)(P.ws + WS_PROJ);
    const float* mu = P.in[11] + (size_t)l * SHIFT_W;
    __syncthreads();
    if (tid < NMB * 128) {
        const int tok = tid >> 3, seg = (tid & 7) * 16;
        const int R = Rbase + tok;
        bool first; const float* st = nullptr;
        if (R < MP) first = (R & 4095) == 0;
        else { const int rs = R - MP; first = (rs & 15) == 0; st = P.in[5] + (size_t)(l * 16 + (rs >> 4)) * SHIFT_W; }
        const u16* pc = proj + (size_t)R * NIN + OFF_SHIFT + 3072 + seg;
        float cur[16], prv[16];
        unpack8(*(const u32x4*)pc, cur); unpack8(*(const u32x4*)(pc + 8), cur + 8);
        if (!first) { unpack8(*(const u32x4*)(pc - NIN), prv); unpack8(*(const u32x4*)(pc - NIN + 8), prv + 8); }
        else {
#pragma unroll
            for (int e = 0; e < 16; ++e) prv[e] = st ? st[3072 + seg + e] : 0.f;
        }
        float xs[16];
#pragma unroll
        for (int e = 0; e < 16; ++e) { xs[e] = cur[e] + (prv[e] - cur[e]) * mu[3072 + seg + e]; if (seg < 64) xs[e] = tanhf(xs[e]); }
        u16* dstp = seg < 64 ? A1 + tok * 72 + seg : A2 + tok * 72 + (seg - 64);
        u32x4 w0, w1;
        w0.x = pk_bf16(xs[0], xs[1]); w0.y = pk_bf16(xs[2], xs[3]); w0.z = pk_bf16(xs[4], xs[5]); w0.w = pk_bf16(xs[6], xs[7]);
        w1.x = pk_bf16(xs[8], xs[9]); w1.y = pk_bf16(xs[10], xs[11]); w1.z = pk_bf16(xs[12], xs[13]); w1.w = pk_bf16(xs[14], xs[15]);
        *(u32x4*)dstp = w0; *(u32x4*)(dstp + 8) = w1;
    }
    __syncthreads();
    float* decay = (float*)(P.ws + WS_DEC); float* aa = (float*)(P.ws + WS_AA);
#pragma unroll 1
    for (int mat = 0; mat < 2; ++mat) {
        const u16* A = mat ? A2 : A1;
        const u16* Wt = (const u16*)(P.ws + (mat ? WS_AUPT : WS_WUPT)) + (size_t)l * 1024 * 64;
        const float* bias = (mat ? P.in[14] : P.in[12]) + (size_t)l * 1024;
        float* dstm = mat ? aa : decay;
        bf16x8 af[NMB][2];
#pragma unroll
        for (int mb = 0; mb < NMB; ++mb)
#pragma unroll
            for (int ks = 0; ks < 2; ++ks) af[mb][ks] = *(const bf16x8*)(A + (mb * 16 + fr) * 72 + ks * 32 + fq * 8);
#pragma unroll 2
        for (int nb = 0; nb < 8; ++nb) {
            const int n = w * 128 + nb * 16 + fr;
            bf16x8 bfr[2];
#pragma unroll
            for (int ks = 0; ks < 2; ++ks) bfr[ks] = *(const bf16x8*)(Wt + (size_t)n * 64 + ks * 32 + fq * 8);
            const int c = w * 128 + nb * 16 + fq * 4;
            const f32x4 bi = *(const f32x4*)(bias + c);
#pragma unroll
            for (int mb = 0; mb < NMB; ++mb) {
                f32x4 a = {0.f, 0.f, 0.f, 0.f};
#pragma unroll
                for (int ks = 0; ks < 2; ++ks) a = __builtin_amdgcn_mfma_f32_16x16x32_bf16(bfr[ks], af[mb][ks], a, 0, 0, 0);
                const int R = Rbase + mb * 16 + fr;
                f32x4 o;
#pragma unroll
                for (int j = 0; j < 4; ++j) { const float s = sigm(bi[j] + a[j]); o[j] = mat ? s : __expf(-0.60653066f * s); }
                *(f32x4*)(dstm + (size_t)R * 1024 + c) = o;
            }
        }
    }
}

typedef float f32x2 __attribute__((ext_vector_type(2)));
__device__ __forceinline__ void scan_item(const Params& P, int l, int v, unsigned char* smem, const int c0 = 0, int c1 = -1, const bool resume = false) {
    const int tid = opaque_tid(), w = tid >> 6, lane = tid & 63;
    float* sm = (float*)smem;
    float* bufs = sm;
    float* ybuf = sm + 2 * 16 * 384;
    const bool samp = v >= 64;
    int b, h, T; size_t row0;
    { const int chain = samp ? v - 64 : v; b = chain >> 4; h = chain & 15; }
    if (!samp) { T = 4096; row0 = (size_t)b * 4096; } else { T = 16; row0 = (size_t)MP + (size_t)b * 16; }
    const int nch = (c1 < 0 || c1 > (T >> 4)) ? (T >> 4) : c1;
    const u16* proj = (const u16*)(P.ws + WS_PROJ);
    __syncthreads();
    if (w < 4) {
        const int i0 = w * 16 + (lane >> 3), i1 = i0 + 8, js = (lane & 7) * 8;
        f32x2 S0, S1, S2, S3, T0, T1, T2, T3;
        if (samp) {
            const float* s0 = P.in[4] + ((size_t)(l * 16 + b) * 16 + h) * 4096 + js;
            const f32x4 a0 = *(const f32x4*)(s0 + i0 * 64), a1 = *(const f32x4*)(s0 + i0 * 64 + 4), c0 = *(const f32x4*)(s0 + i1 * 64), c1 = *(const f32x4*)(s0 + i1 * 64 + 4);
            S0 = a0.xy; S1 = a0.zw; S2 = a1.xy; S3 = a1.zw; T0 = c0.xy; T1 = c0.zw; T2 = c1.xy; T3 = c1.zw;
        } else if (resume) {
            const float* s0 = P.out + O_RP + ((size_t)(l * 4 + b) * 16 + h) * 4096 + js;
            const f32x4 a0 = *(const f32x4*)(s0 + i0 * 64), a1 = *(const f32x4*)(s0 + i0 * 64 + 4), c0v = *(const f32x4*)(s0 + i1 * 64), c1v = *(const f32x4*)(s0 + i1 * 64 + 4);
            S0 = a0.xy; S1 = a0.zw; S2 = a1.xy; S3 = a1.zw; T0 = c0v.xy; T1 = c0v.zw; T2 = c1v.xy; T3 = c1v.zw;
        } else { S0 = (f32x2){0.f, 0.f}; S1 = S0; S2 = S0; S3 = S0; T0 = S0; T1 = S0; T2 = S0; T3 = S0; }
        __syncthreads();
        for (int c = c0; c < nch; ++c) {
            const float* bb = bufs + (c & 1) * (16 * 384) + js;
            const float* bv = bufs + (c & 1) * (16 * 384) + 320 + i0;
            float* yb = ybuf + (c & 1) * 8192 + w * 64 + lane;
            f32x4 w0, w1, a0, a1, b0, b1, k0, k1, r0, r1; float vi, vj;
            f32x4 W0, W1, A0, A1, B0, B1, K0, K1, R0, R1; float VI, VJ;
#define SCAN_LOAD(w0, w1, a0, a1, b0, b1, k0, k1, r0, r1, vi, vj, t) do { const float* vb = bb + (t) * 384; \
                w0 = *(const f32x4*)(vb); w1 = *(const f32x4*)(vb + 4); a0 = *(const f32x4*)(vb + 64); a1 = *(const f32x4*)(vb + 68); \
                b0 = *(const f32x4*)(vb + 128); b1 = *(const f32x4*)(vb + 132); k0 = *(const f32x4*)(vb + 192); k1 = *(const f32x4*)(vb + 196); \
                r0 = *(const f32x4*)(vb + 256); r1 = *(const f32x4*)(vb + 260); vi = bv[(t) * 384]; vj = bv[(t) * 384 + 8]; } while (0)
#define SCAN_ROW(S0, S1, S2, S3, w0, w1, a0, a1, b0, b1, k0, k1, r0, r1, vi, yslot) do { const f32x2 vi2 = {vi, vi}; \
                f32x2 p = S0 * a0.xy; p = S1 * a0.zw + p; f32x2 q = S2 * a1.xy; q = S3 * a1.zw + q; \
                const f32x2 sw0 = S0 * w0.xy + vi2 * k0.xy, sw1 = S1 * w0.zw + vi2 * k0.zw, sw2 = S2 * w1.xy + vi2 * k1.xy, sw3 = S3 * w1.zw + vi2 * k1.zw; \
                p = p + q; const float dot = red8(p.x + p.y); const f32x2 d2 = {dot, dot}; \
                S0 = d2 * b0.xy + sw0; S1 = d2 * b0.zw + sw1; S2 = d2 * b1.xy + sw2; S3 = d2 * b1.zw + sw3; \
                f32x2 yp = S0 * r0.xy; yp = S1 * r0.zw + yp; f32x2 yq = S2 * r1.xy; yq = S3 * r1.zw + yq; yp = yp + yq; \
                yb[yslot] = yp.x + yp.y; } while (0)
#define SCAN_STEP(w0, w1, a0, a1, b0, b1, k0, k1, r0, r1, vi, vj, t) do { \
                SCAN_ROW(S0, S1, S2, S3, w0, w1, a0, a1, b0, b1, k0, k1, r0, r1, vi, (t) * 512); \
                SCAN_ROW(T0, T1, T2, T3, w0, w1, a0, a1, b0, b1, k0, k1, r0, r1, vj, (t) * 512 + 256); } while (0)
            SCAN_LOAD(w0, w1, a0, a1, b0, b1, k0, k1, r0, r1, vi, vj, 0);
#pragma unroll
            for (int t = 0; t < 16; t += 2) {
                SCAN_LOAD(W0, W1, A0, A1, B0, B1, K0, K1, R0, R1, VI, VJ, t + 1);
                SCAN_STEP(w0, w1, a0, a1, b0, b1, k0, k1, r0, r1, vi, vj, t);
                if (t + 2 < 16) SCAN_LOAD(w0, w1, a0, a1, b0, b1, k0, k1, r0, r1, vi, vj, t + 2);
                SCAN_STEP(W0, W1, A0, A1, B0, B1, K0, K1, R0, R1, VI, VJ, t + 1);
            }
#undef SCAN_LOAD
#undef SCAN_ROW
#undef SCAN_STEP
            __syncthreads();
        }
        float* so = P.out + (samp ? O_RS + ((size_t)(l * 16 + b) * 16 + h) * 4096 : O_RP + ((size_t)(l * 4 + b) * 16 + h) * 4096) + js;
        f32x4 o0, o1; o0.xy = S0; o0.zw = S1; o1.xy = S2; o1.zw = S3;
        *(f32x4*)(so + i0 * 64) = o0; *(f32x4*)(so + i0 * 64 + 4) = o1;
        o0.xy = T0; o0.zw = T1; o1.xy = T2; o1.zw = T3;
        *(f32x4*)(so + i1 * 64) = o0; *(f32x4*)(so + i1 * 64 + 4) = o1;
    } else {
        const int pw = w - 4;
        const float* decay = (const float*)(P.ws + WS_DEC); const float* aa = (const float*)(P.ws + WS_AA);
        float* yraw = (float*)(P.ws + WS_YRAW);
        const int col = h * 64 + lane;
        const float mu_r = P.in[11][(size_t)l * SHIFT_W + col], mu_k = P.in[11][(size_t)l * SHIFT_W + 1024 + col], mu_v = P.in[11][(size_t)l * SHIFT_W + 2048 + col];
        const float c_kk = P.in[16][l * 1024 + col], c_ka = P.in[17][l * 1024 + col];
        const float* sh0 = samp ? P.in[5] + (size_t)(l * 16 + b) * SHIFT_W : nullptr;
        float pr[2][4], pk[2][4], pv[2][4], qr[2][4], qk[2][4], qv[2][4], pd[2][4], pa[2][4];
        auto prep_load = [&](int c, auto SET) {
            constexpr int s = decltype(SET)::value;
#pragma unroll
            for (int u = 0; u < 4; ++u) {
                const int t = c * 16 + pw + u * 4;
                const u16* p = proj + (row0 + t) * NIN + OFF_SHIFT + col;
                pr[s][u] = bf2f(p[0]); pk[s][u] = bf2f(p[1024]); pv[s][u] = bf2f(p[2048]);
                if (t > 0) { qr[s][u] = bf2f(p[-NIN]); qk[s][u] = bf2f(p[1024 - NIN]); qv[s][u] = bf2f(p[2048 - NIN]); }
                else if (sh0) { qr[s][u] = sh0[col]; qk[s][u] = sh0[1024 + col]; qv[s][u] = sh0[2048 + col]; }
                else { qr[s][u] = 0.f; qk[s][u] = 0.f; qv[s][u] = 0.f; }
                pd[s][u] = decay[(row0 + t) * 1024 + col]; pa[s][u] = aa[(row0 + t) * 1024 + col];
            }
        };
        auto prep_store = [&](int c, auto SET) {
            constexpr int s = decltype(SET)::value;
            float* bb = bufs + (c & 1) * (16 * 384);
#pragma unroll
            for (int u = 0; u < 4; ++u) {
                const int tl = pw + u * 4;
                const float xr = pr[s][u] + (qr[s][u] - pr[s][u]) * mu_r, xk = pk[s][u] + (qk[s][u] - pk[s][u]) * mu_k, xv = pv[s][u] + (qv[s][u] - pv[s][u]) * mu_v;
                const float kkr = xk * c_kk;
                const float n2 = wave_sum(kkr * kkr);
                const float kk = kkr / fmaxf(sqrtf(n2), 1e-12f);
                const float kp = xk * (1.f + (pa[s][u] - 1.f) * c_ka);
                float* o = bb + tl * 384 + lane;
                o[0] = pd[s][u]; o[64] = -kk; o[128] = kk * pa[s][u]; o[192] = kp; o[256] = xr; o[320] = xv;
            }
        };
        auto drain = [&](int c) {
            const float* yb = ybuf + (c & 1) * 8192;
            const int pt = tid - 256, t = pt >> 4, rq = pt & 15;
            const float* src = yb + t * 512 + ((rq & 3) >> 1) * 256 + (rq >> 2) * 64 + (rq & 1) * 32;
            f32x4 o;
#pragma unroll
            for (int e = 0; e < 4; ++e) {
                const f32x4 y0 = *(const f32x4*)(src + e * 8), y1 = *(const f32x4*)(src + e * 8 + 4);
                o[e] = ((y0[0] + y0[1]) + (y0[2] + y0[3])) + ((y1[0] + y1[1]) + (y1[2] + y1[3]));
            }
            *(f32x4*)(yraw + (row0 + c * 16 + t) * 1024 + h * 64 + rq * 4) = o;
        };
        using I0 = std::integral_constant<int, 0>; using I1 = std::integral_constant<int, 1>;
        prep_load(c0, I0{}); prep_store(c0, I0{});
        if (c0 + 1 < nch) prep_load(c0 + 1, I1{});
        if (c0 + 2 < nch) prep_load(c0 + 2, I0{});
        __syncthreads();
        for (int c = c0; c < nch; c += 2) {
            if (c + 1 < nch) prep_store(c + 1, I1{});
            if (c + 3 < nch) prep_load(c + 3, I1{});
            if (c > c0) drain(c - 1);
            __syncthreads();
            if (c + 1 < nch) {
                if (c + 2 < nch) prep_store(c + 2, I0{});
                if (c + 4 < nch) prep_load(c + 4, I0{});
                drain(c);
                __syncthreads();
            }
        }
        drain(nch - 1);
    }
}

__device__ __forceinline__ float red16(float x) { x += dppf<0xB1>(x); x += dppf<0x4E>(x); x += dppf<0x141>(x); x += dppf<0x140>(x); return x; }
__device__ __forceinline__ void rwkv_post_rows(const Params& P, int l, int rbeg, int rend) {
    const int tid = opaque_tid(), w = tid >> 6, lane = tid & 63;
    u16* proj = (u16*)(P.ws + WS_PROJ);
    const float* aa = (const float*)(P.ws + WS_AA); const float* yraw = (const float*)(P.ws + WS_YRAW);
    const float* mu = P.in[11] + (size_t)l * SHIFT_W;
#pragma unroll 1
    for (int R = rbeg + w; R < rend; R += 8) {
        bool first; const float* st = nullptr;
        if (R < MP) first = (R & 4095) == 0;
        else { const int rs = R - MP; first = (rs & 15) == 0; st = P.in[5] + (size_t)(l * 16 + (rs >> 4)) * SHIFT_W; }
#pragma unroll
        for (int hq = 0; hq < 4; ++hq) {
            const int col = hq * 256 + lane * 4;
            const u16* p = proj + (size_t)R * NIN + OFF_SHIFT + col;
            const u32x2 cr = *(const u32x2*)p, ck = *(const u32x2*)(p + 1024), cv = *(const u32x2*)(p + 2048);
            float pr[4] = {lo_bf(cr.x), hi_bf(cr.x), lo_bf(cr.y), hi_bf(cr.y)}, pk[4] = {lo_bf(ck.x), hi_bf(ck.x), lo_bf(ck.y), hi_bf(ck.y)},
                  pv[4] = {lo_bf(cv.x), hi_bf(cv.x), lo_bf(cv.y), hi_bf(cv.y)};
            float qr[4], qk[4], qv[4];
            if (!first) {
                const u32x2 dr = *(const u32x2*)(p - NIN), dk = *(const u32x2*)(p + 1024 - NIN), dv = *(const u32x2*)(p + 2048 - NIN);
                qr[0] = lo_bf(dr.x); qr[1] = hi_bf(dr.x); qr[2] = lo_bf(dr.y); qr[3] = hi_bf(dr.y);
                qk[0] = lo_bf(dk.x); qk[1] = hi_bf(dk.x); qk[2] = lo_bf(dk.y); qk[3] = hi_bf(dk.y);
                qv[0] = lo_bf(dv.x); qv[1] = hi_bf(dv.x); qv[2] = lo_bf(dv.y); qv[3] = hi_bf(dv.y);
            } else {
#pragma unroll
                for (int e = 0; e < 4; ++e) { qr[e] = st ? st[col + e] : 0.f; qk[e] = st ? st[1024 + col + e] : 0.f; qv[e] = st ? st[2048 + col + e] : 0.f; }
            }
            const f32x4 mr = *(const f32x4*)(mu + col), mk = *(const f32x4*)(mu + 1024 + col), mv = *(const f32x4*)(mu + 2048 + col);
            const f32x4 a = *(const f32x4*)(aa + (size_t)R * 1024 + col);
            const f32x4 ka = *(const f32x4*)(P.in[17] + l * 1024 + col), rk = *(const f32x4*)(P.in[18] + l * 1024 + col);
            const f32x4 gw = *(const f32x4*)(P.in[19] + l * 1024 + col), gb = *(const f32x4*)(P.in[20] + l * 1024 + col);
            const f32x4 y = *(const f32x4*)(yraw + (size_t)R * 1024 + col);
            float xv[4], bon = 0.f;
#pragma unroll
            for (int e = 0; e < 4; ++e) {
                const float xr = pr[e] + (qr[e] - pr[e]) * mr[e], xk = pk[e] + (qk[e] - pk[e]) * mk[e];
                xv[e] = pv[e] + (qv[e] - pv[e]) * mv[e];
                bon += xr * (xk * (1.f + (a[e] - 1.f) * ka[e])) * rk[e];
            }
            bon = red16(bon);
            const float mean = red16(y[0] + y[1] + y[2] + y[3]) * (1.f / 64.f);
            float d[4], vs = 0.f;
#pragma unroll
            for (int e = 0; e < 4; ++e) { d[e] = y[e] - mean; vs += d[e] * d[e]; }
            const float rstd = rsqrtf(red16(vs) * (1.f / 64.f) + 64e-5f);
            u16* gp = proj + (size_t)R * NIN + OFF_GATE + 1024 + col;
            const u32x2 gz = *(const u32x2*)gp;
            float o[4];
#pragma unroll
            for (int e = 0; e < 4; ++e) o[e] = d[e] * rstd * gw[e] + gb[e] + bon * xv[e];
            u32x2 ow; ow.x = pk_bf16(o[0] * lo_bf(gz.x), o[1] * hi_bf(gz.x)); ow.y = pk_bf16(o[2] * lo_bf(gz.y), o[3] * hi_bf(gz.y));
            *(u32x2*)gp = ow;
        }
    }
}

__device__ __forceinline__ void pool_item(const Params& P, int l, int item, unsigned char* smem) {
    const int tid = opaque_tid(), w = tid >> 6, lane = tid & 63, fr = lane & 15, fq = lane >> 4;
    const int tile = item >> 2, g = item & 3;
    u16* At = (u16*)smem;
    u16* proj = (u16*)(P.ws + WS_PROJ);
    __syncthreads();
    {
        const int cp = tid & 127, tq = tid >> 7;
        const int c = g * 256 + cp * 2;
        auto build = [&](auto WINC) {
            constexpr int WIN = decltype(WINC)::value;
#pragma unroll 1
            for (int sub = 0; sub < 2; ++sub) {
                const int unit = tq * 2 + sub;
                const int R0 = tile * 128 + unit * 16;
                const bool samp = R0 >= MP;
                int t0; const float* hist = nullptr;
                if (!samp) t0 = R0 & 4095; else { t0 = 0; hist = P.in[6] + (size_t)(l * 16 + ((R0 - MP) >> 4)) * 15 * 1024; }
                float u0[WIN - 1 + 16], u1[WIN - 1 + 16];
#pragma unroll
                for (int k = 0; k < WIN - 1 + 16; ++k) {
                    const int dt = k - (WIN - 1), t = t0 + dt;
                    if (t >= 0) { const unsigned wv = *(const unsigned*)(proj + (size_t)(R0 + dt) * NIN + c); u0[k] = lo_bf(wv); u1[k] = hi_bf(wv); }
                    else if (hist) { const float* hp = hist + (size_t)(15 + t) * 1024 + c; u0[k] = hp[0]; u1[k] = hp[1]; }
                    else { u0[k] = 0.f; u1[k] = 0.f; }
                }
                float s0 = 0.f, s1 = 0.f;
#pragma unroll
                for (int k = 0; k < WIN - 1; ++k) { s0 += u0[k]; s1 += u1[k]; }
#pragma unroll
                for (int tt = 0; tt < 16; ++tt) {
                    s0 += u0[WIN - 1 + tt]; s1 += u1[WIN - 1 + tt];
                    const int pos = t0 + tt;
                    const float cnt = samp ? (float)WIN : (float)((pos + 1) < WIN ? (pos + 1) : WIN);
                    const float inv = 1.f / cnt;
                    *(unsigned*)(At + (unit * 16 + tt) * 264 + cp * 2) = pk_bf16(s0 * inv - u0[WIN - 1 + tt], s1 * inv - u1[WIN - 1 + tt]);
                    s0 -= u0[tt]; s1 -= u1[tt];
                }
            }
        };
        if (g == 0) build(std::integral_constant<int, 2>{});
        else if (g == 1) build(std::integral_constant<int, 4>{});
        else if (g == 2) build(std::integral_constant<int, 8>{});
        else build(std::integral_constant<int, 16>{});
    }
    __syncthreads();
    const u16* Wt = (const u16*)(P.ws + WS_WTPOOL) + (size_t)(l * 4 + g) * 65536;
    const int mrow0 = (w & 1) * 64, ncol0 = (w >> 1) * 64;
    f32x4 acc[4][4];
#pragma unroll
    for (int a = 0; a < 4; ++a)
#pragma unroll
        for (int b = 0; b < 4; ++b) acc[a][b] = (f32x4){0.f, 0.f, 0.f, 0.f};
#pragma unroll 2
    for (int ks = 0; ks < 8; ++ks) {
        bf16x8 af[4], bfr[4];
#pragma unroll
        for (int mb = 0; mb < 4; ++mb) af[mb] = *(const bf16x8*)(At + (mrow0 + mb * 16 + fr) * 264 + ks * 32 + fq * 8);
#pragma unroll
        for (int nb = 0; nb < 4; ++nb) bfr[nb] = *(const bf16x8*)(Wt + (size_t)(ncol0 + nb * 16 + fr) * 256 + ks * 32 + fq * 8);
#pragma unroll
        for (int nb = 0; nb < 4; ++nb)
#pragma unroll
            for (int mb = 0; mb < 4; ++mb) acc[nb][mb] = __builtin_amdgcn_mfma_f32_16x16x32_bf16(bfr[nb], af[mb], acc[nb][mb], 0, 0, 0);
    }
    const float* psc = P.in[10] + (size_t)l * 1024;
#pragma unroll
    for (int nb = 0; nb < 4; ++nb) {
        const int colg = g * 256 + ncol0 + nb * 16 + fq * 4;
        const f32x4 sc = *(const f32x4*)(psc + colg);
#pragma unroll
        for (int mb = 0; mb < 4; ++mb) {
            const int R = tile * 128 + mrow0 + mb * 16 + fr;
            u16* gp = proj + (size_t)R * NIN + OFF_GATE + colg;
            const u32x2 gz = *(const u32x2*)gp;
            u32x2 o;
            o.x = pk_bf16(acc[nb][mb][0] * sc[0] * lo_bf(gz.x), acc[nb][mb][1] * sc[1] * hi_bf(gz.x));
            o.y = pk_bf16(acc[nb][mb][2] * sc[2] * lo_bf(gz.y), acc[nb][mb][3] * sc[3] * hi_bf(gz.y));
            *(u32x2*)gp = o;
        }
    }
}

__device__ __forceinline__ int t5_bucket_n(int n) {
    const int ret = n < 0 ? 16 : 0;
    n = n < 0 ? -n : n;
    int v;
    if (n < 8) v = n; else if (n < 12) v = 8; else if (n < 16) v = 9; else if (n < 23) v = 10; else if (n < 32) v = 11;
    else if (n < 46) v = 12; else if (n < 64) v = 13; else if (n < 91) v = 14; else v = 15;
    return ret + v;
}
__device__ __forceinline__ void attn_item(const Params& P, int l, int item, unsigned char* smem) {
    const int tid = opaque_tid(), w = tid >> 6, lane = tid & 63, lq = lane & 31, hh = lane >> 5;
    u16* Ks = (u16*)smem;
    u16* Vt = Ks + 192 * 72;
    float* biasT = (float*)(Vt + 64 * 200);
    u16* proj = (u16*)(P.ws + WS_PROJ);
    const bool samp = item >= 1024;
    int b, nc = 0, kh;
    if (!samp) { b = item >> 8; nc = (item >> 2) & 63; kh = item & 3; } else { const int it = item - 1024; b = it >> 2; kh = it & 3; }
    const size_t qrow0 = samp ? (size_t)MP + (size_t)b * 16 : (size_t)b * 4096 + (size_t)nc * 64;
    __syncthreads();
    for (int idx = tid; idx < 1536; idx += 512) {
        const int s = idx >> 3, d0 = (idx & 7) * 8;
        float kf[8], vf[8];
        bool valid = true, fromproj = true; size_t row = 0;
        if (!samp) { const int tk = nc * 64 - 128 + s; if (tk < 0) valid = false; else row = (size_t)b * 4096 + tk; }
        else { if (s < 128) fromproj = false; else if (s < 144) row = (size_t)MP + (size_t)b * 16 + (s - 128); else valid = false; }
        if (!valid) {
#pragma unroll
            for (int e = 0; e < 8; ++e) { kf[e] = 0.f; vf[e] = 0.f; }
        } else if (fromproj) {
            unpack8(*(const u32x4*)(proj + row * NIN + OFF_K + kh * 64 + d0), kf);
            unpack8(*(const u32x4*)(proj + row * NIN + OFF_V + kh * 64 + d0), vf);
        } else {
            const size_t o = (((size_t)(l * 16 + b) * 128 + s) * 4 + kh) * 64 + d0;
            const f32x4 k0 = *(const f32x4*)(P.in[2] + o), k1 = *(const f32x4*)(P.in[2] + o + 4);
            const f32x4 v0 = *(const f32x4*)(P.in[3] + o), v1 = *(const f32x4*)(P.in[3] + o + 4);
#pragma unroll
            for (int e = 0; e < 4; ++e) { kf[e] = k0[e]; kf[4 + e] = k1[e]; vf[e] = v0[e]; vf[4 + e] = v1[e]; }
        }
        u32x4 kw; kw.x = pk_bf16(kf[0], kf[1]); kw.y = pk_bf16(kf[2], kf[3]); kw.z = pk_bf16(kf[4], kf[5]); kw.w = pk_bf16(kf[6], kf[7]);
        *(u32x4*)(Ks + s * 72 + d0) = kw;
#pragma unroll
        for (int e = 0; e < 8; ++e) Vt[(d0 + e) * 200 + s] = f2bf(vf[e]);
    }
    for (int idx = tid; idx < 1024; idx += 512) {
        const int g = idx >> 8, x = idx & 255;
        biasT[idx] = P.in[22][t5_bucket_n(x - 63) * 16 + kh * 4 + g];
    }
    __syncthreads();
    const int nrows = samp ? 64 : 256;
    if (w * 32 < nrows) {
        const int r = w * 32 + lq;
        int g, t;
        if (!samp) { g = r >> 6; t = r & 63; } else { g = r >> 4; t = r & 15; }
        const int head = kh * 4 + g;
        const size_t qrow = qrow0 + t;
        bf16x8 qf[4];
#pragma unroll
        for (int ks = 0; ks < 4; ++ks) qf[ks] = *(const bf16x8*)(proj + qrow * NIN + OFF_Q + head * 64 + ks * 16 + hh * 8);
        const int kb_lo = samp ? 0 : (nc >= 2 ? 0 : (2 - nc) * 2);
        const int kb_hi = samp ? 5 : 6;
        f32x16 sc[6];
#pragma unroll
        for (int kb = 0; kb < 6; ++kb) {
#pragma unroll
            for (int j = 0; j < 16; ++j) sc[kb][j] = 0.f;
            if (kb >= kb_lo && kb < kb_hi) {
#pragma unroll
                for (int ks = 0; ks < 4; ++ks) {
                    const bf16x8 kf = *(const bf16x8*)(Ks + (kb * 32 + lq) * 72 + ks * 16 + hh * 8);
                    sc[kb] = __builtin_amdgcn_mfma_f32_32x32x16_bf16(kf, qf[ks], sc[kb], 0, 0, 0);
                }
            }
        }
        const float sink = P.in[21][l * 16 + head];
        const float* bt = biasT + g * 256 + 63 + t + 128;
        float mx = sink;
#pragma unroll
        for (int kb = 0; kb < 6; ++kb) {
            if (kb >= kb_lo && kb < kb_hi) {
#pragma unroll
                for (int j = 0; j < 16; ++j) {
                    const int key = kb * 32 + 8 * (j >> 2) + 4 * hh + (j & 3);
                    float lg = sc[kb][j] * 0.125f + bt[-key];
                    if (samp && key >= 144) lg = -1e30f;
                    sc[kb][j] = lg; mx = fmaxf(mx, lg);
                }
            }
        }
        mx = fmaxf(mx, __shfl_xor(mx, 32));
        float sum = 0.f;
#pragma unroll
        for (int kb = 0; kb < 6; ++kb) {
            if (kb >= kb_lo && kb < kb_hi) {
#pragma unroll
                for (int j = 0; j < 16; ++j) { const float p = __expf(sc[kb][j] - mx); sc[kb][j] = p; sum += p; }
            }
        }
        sum += __shfl_xor(sum, 32);
        sum += __expf(sink - mx);
        const float inv = 1.f / sum;
        f32x16 oacc[2];
#pragma unroll
        for (int db = 0; db < 2; ++db)
#pragma unroll
            for (int j = 0; j < 16; ++j) oacc[db][j] = 0.f;
#pragma unroll
        for (int kb = 0; kb < 6; ++kb) {
            if (kb >= kb_lo && kb < kb_hi) {
#pragma unroll
                for (int k2 = 0; k2 < 2; ++k2) {
                    u32x4 pw;
                    pw.x = pk_bf16(sc[kb][8 * k2 + 0], sc[kb][8 * k2 + 1]); pw.y = pk_bf16(sc[kb][8 * k2 + 2], sc[kb][8 * k2 + 3]);
                    pw.z = pk_bf16(sc[kb][8 * k2 + 4], sc[kb][8 * k2 + 5]); pw.w = pk_bf16(sc[kb][8 * k2 + 6], sc[kb][8 * k2 + 7]);
                    bf16x8 pf; __builtin_memcpy(&pf, &pw, 16);
#pragma unroll
                    for (int db = 0; db < 2; ++db) {
                        const u16* vp = Vt + (db * 32 + lq) * 200 + kb * 32 + 16 * k2 + 4 * hh;
                        u32x4 vw; const u32x2 va = *(const u32x2*)vp, vb2 = *(const u32x2*)(vp + 8);
                        vw.x = va.x; vw.y = va.y; vw.z = vb2.x; vw.w = vb2.y;
                        bf16x8 vfr; __builtin_memcpy(&vfr, &vw, 16);
                        oacc[db] = __builtin_amdgcn_mfma_f32_32x32x16_bf16(vfr, pf, oacc[db], 0, 0, 0);
                    }
                }
            }
        }
#pragma unroll
        for (int db = 0; db < 2; ++db)
#pragma unroll
            for (int jq = 0; jq < 4; ++jq) {
                const int d = db * 32 + 8 * jq + 4 * hh;
                u16* gp = proj + qrow * NIN + OFF_GATE + 2048 + head * 64 + d;
                const u32x2 gz = *(const u32x2*)gp;
                u32x2 o;
                o.x = pk_bf16(oacc[db][4 * jq + 0] * inv * lo_bf(gz.x), oacc[db][4 * jq + 1] * inv * hi_bf(gz.x));
                o.y = pk_bf16(oacc[db][4 * jq + 2] * inv * lo_bf(gz.y), oacc[db][4 * jq + 3] * inv * hi_bf(gz.y));
                *(u32x2*)gp = o;
            }
    }
}

#define XB_TMO      128
#define XB_XCNT(j)  (256  + 64 * (j))
#define XB_XSUB(j)  (1280 + 64 * (j))
#define XB_XGEN(j)  (2304 + 64 * (j))
#define XB_TOP      3328
#define XB_TOPGEN   3392
#define XCD_BAR_WORDS 3456
#define XB_SPIN_CAP (1u << 20)
__device__ __forceinline__ unsigned xb_ld(unsigned* p)              { return __hip_atomic_load(p, __ATOMIC_RELAXED, __HIP_MEMORY_SCOPE_AGENT); }
__device__ __forceinline__ unsigned xb_add(unsigned* p, unsigned v) { return __hip_atomic_fetch_add(p, v, __ATOMIC_RELAXED, __HIP_MEMORY_SCOPE_AGENT); }
__device__ __forceinline__ unsigned xb_xcc_id() { return (unsigned)__builtin_amdgcn_s_getreg((3 << 11) | 20) & 0xFu; }
#define XB_SPIN(cond, bar) do { unsigned _sp = 0; while (cond) { __builtin_amdgcn_s_sleep(1); \
    if ((++_sp & 255u) == 0u) { if (xb_ld(&(bar)[XB_TMO])) break; if (_sp > XB_SPIN_CAP) { atomicAdd(&(bar)[XB_TMO], 1u); break; } } } } while (0)
struct XcdBarrier { unsigned* bar; unsigned x; volatile LAS unsigned* st; };
__device__ __forceinline__ XcdBarrier xcd_barrier_post(unsigned* bar, volatile LAS unsigned* st) {
    XcdBarrier b; b.bar = bar; b.x = xb_xcc_id(); b.st = st;
    if (opaque_tid() == 0) (void)xb_add(&bar[XB_XCNT(b.x)], 1u);
    return b;
}
__device__ __forceinline__ void xcd_barrier_complete(unsigned* bar, unsigned x, unsigned& nloc, unsigned& nx) {
    const unsigned G = gridDim.x;
    unsigned sum, cnt, mine, sp = 0u;
    for (;;) {
        sum = 0u; cnt = 0u; mine = 0u;
#pragma unroll
        for (unsigned j = 0; j < 16; ++j) { const unsigned c = xb_ld(&bar[XB_XCNT(j)]); sum += c; cnt += (c > 0u) ? 1u : 0u; mine = (j == x) ? c : mine; }
        if (sum == G) break;
        __builtin_amdgcn_s_sleep(1);
        if ((++sp & 255u) == 0u) { if (xb_ld(&bar[XB_TMO])) break; if (sp > XB_SPIN_CAP) { atomicAdd(&bar[XB_TMO], 1u); break; } }
    }
    nloc = mine > 0u ? mine : 1u; nx = cnt > 0u ? cnt : 1u;
}
__device__ __forceinline__ void xcd_barrier(const XcdBarrier& b) {
    asm volatile("s_waitcnt vmcnt(0)" ::: "memory");
    __syncthreads();
    if (opaque_tid() == 0) {
        unsigned* bar = b.bar;
        __builtin_amdgcn_s_waitcnt(0);
        unsigned nloc = b.st[0], nx = b.st[1];
        if (nloc == 0u) { xcd_barrier_complete(bar, b.x, nloc, nx); b.st[0] = nloc; b.st[1] = nx; }
        const unsigned old = xb_add(&bar[XB_XSUB(b.x)], 1u);
        const unsigned gen = old / nloc;
        if (old + 1u == (gen + 1u) * nloc) {
            __builtin_amdgcn_fence(__ATOMIC_RELEASE, "agent");
            asm volatile("s_waitcnt vmcnt(0)" ::: "memory");
            const unsigned og = xb_add(&bar[XB_TOP], 1u);
            const unsigned tg = og / nx;
            if (og + 1u == (tg + 1u) * nx) xb_add(&bar[XB_TOPGEN], 1u);
            else XB_SPIN(xb_ld(&bar[XB_TOPGEN]) == tg, bar);
            __builtin_amdgcn_fence(__ATOMIC_ACQUIRE, "agent");
            xb_add(&bar[XB_XGEN(b.x)], 1u);
            asm volatile("s_waitcnt vmcnt(0)" ::: "memory");
        } else {
            XB_SPIN(xb_ld(&bar[XB_XGEN(b.x)]) == gen, bar);
            __builtin_amdgcn_fence(__ATOMIC_ACQUIRE, "agent");
            asm volatile("s_waitcnt vmcnt(0)" ::: "memory");
        }
    }
    __syncthreads();
}

template <int l>
__device__ __forceinline__ void layer_body(const Params& P, const XcdBarrier& xb, unsigned char* smem) {
    const int G = gridDim.x, bid = blockIdx.x;
    unsigned* ctl = (unsigned*)(P.ws + WS_CTL);
    u16* wtin = (u16*)(P.ws + WS_WTIN); u16* wtbr = (u16*)(P.ws + WS_WTBR); u16* wtout = (u16*)(P.ws + WS_WTOUT);
    u16* hbuf = (u16*)(P.ws + WS_H); u16* proj = (u16*)(P.ws + WS_PROJ);
    LAS unsigned char* lds = (LAS unsigned char*)smem;
    LAS int* slot = (LAS int*)(lds + 131072);
        const u16* wt_l = wtin + (size_t)l * NIN_PAD * 2048;
        EpiIn ein{proj};
        { SchedIn S{hbuf, wt_l, 0, nullptr, slot, G, bid, 0, opaque_tid() == 0}; gemm_phase(lds, 2048, 2048, S, ein); }
        xcd_barrier(xb);
        for (int t = bid; t < MP / 64; t += G) rwkv_prep_tile<4>(P, l, t * 64, smem);
        for (int t = bid; t < MS / 16; t += G) rwkv_prep_tile<1>(P, l, MP + t * 16, smem);
        xcd_barrier(xb);
        if (G > 128) {
            if (bid < 64) scan_item(P, l, bid, smem, 0, 192);
            else { SchedIn S{hbuf, wt_l, 1, nullptr, slot, G - 64, bid - 64, 0, false}; gemm_phase(lds, 2048, 2048, S, ein); }
            xcd_barrier(xb);
            if (bid < 64) scan_item(P, l, bid, smem, 192, 256, true);
            else {
                for (int v = bid; v < 320; v += G - 64) scan_item(P, l, v, smem);
                side_outputs(P, l, G - 64, bid - 64);
                for (int it = bid - 64; it < 1088 + 520; it += G - 64) { if (it < 1088) attn_item(P, l, it, smem); else pool_item(P, l, it - 1088, smem); }
            }
            xcd_barrier(xb);
            { const int per = (M + G - 1) / G, rb = bid * per; rwkv_post_rows(P, l, rb, (rb + per) < M ? (rb + per) : M); }
        } else {
            for (int v = bid; v < 320; v += G) scan_item(P, l, v, smem);
            __syncthreads();
            { SchedIn S{hbuf, wt_l, 1, ctl + l * 16, slot, G, bid, 0, opaque_tid() == 0}; gemm_phase(lds, 2048, 2048, S, ein); }
            xcd_barrier(xb);
            side_outputs(P, l, G, bid);
            for (int it = bid; it < 1088 + 520 + 520; it += G) {
                if (it < 1088) attn_item(P, l, it, smem);
                else if (it < 1608) pool_item(P, l, it - 1088, smem);
                else rwkv_post_rows(P, l, (it - 1608) * 32, (it - 1608) * 32 + 32);
            }
        }
        xcd_barrier(xb);
        { SchedBr S{proj, wtbr + (size_t)l * 3 * 2048 * 1024, G, bid}; EpiBr e{proj, hbuf}; __syncthreads(); gemm_phase(lds, 1024, NIN, S, e); }
        for (int t = bid; t < 256; t += G) branch_small(P, l, t, smem);
        xcd_barrier(xb);
        { SchedOut S{hbuf, wtout + (size_t)l * 2048 * 2048, G, bid};
          EpiOut e{l == 0 ? P.in[0] : P.out, l == 0 ? P.in[1] : P.out + (size_t)MP * D, P.out}; gemm_phase(lds, 2048, 2048, S, e); }
        for (int t = bid; t < 256; t += G) out_small(P, l, t, smem);
        xcd_barrier(xb);
        if (l == 0) { rms_rows<true>(P.out, P.out + (size_t)MP * D, P.in[7] + D, hbuf, nullptr); xcd_barrier(xb); }
    }

__global__ void __launch_bounds__(512, 2) fwd_megakernel(Params P) {
    extern __shared__ __attribute__((aligned(16))) unsigned char smem[];
    cg::grid_group grid = cg::this_grid();
    const int G = gridDim.x, bid = blockIdx.x;
    unsigned* ctl = (unsigned*)(P.ws + WS_CTL);
    u16* wtin = (u16*)(P.ws + WS_WTIN); u16* wtbr = (u16*)(P.ws + WS_WTBR); u16* wtout = (u16*)(P.ws + WS_WTOUT);
    u16* wtpool = (u16*)(P.ws + WS_WTPOOL); u16* wupt = (u16*)(P.ws + WS_WUPT); u16* aupt = (u16*)(P.ws + WS_AUPT);
    u16* hbuf = (u16*)(P.ws + WS_H); u16* proj = (u16*)(P.ws + WS_PROJ);
    LAS unsigned char* lds = (LAS unsigned char*)smem;
    LAS int* slot = (LAS int*)(lds + 131072);

    if ((threadIdx.x & 63) == 0) ((volatile int*)(smem + 131072 + 256))[__builtin_amdgcn_s_getreg(10244) & 63] = threadIdx.x >> 6;
    if (threadIdx.x < 4) ((volatile unsigned*)(smem + 131072 + 64))[threadIdx.x] = 0u;
    __syncthreads();
    const XcdBarrier xb = xcd_barrier_post((unsigned*)(P.ws + WS_BAR), (volatile LAS unsigned*)(lds + 131072 + 64));
    if (bid == 0 && opaque_tid() < 64) ctl[opaque_tid()] = 0u;
    {
        int base = 0; float* tile = (float*)smem;
        for (int l = 0; l < 2; ++l) {
            tr_cvt(P.in[8] + (size_t)l * 2048 * NIN, 2048, NIN, wtin + (size_t)l * NIN_PAD * 2048, base, tile);
            for (int b = 0; b < 3; ++b) tr_cvt(P.in[23] + (size_t)(l * 3 + b) * 1024 * 2048, 1024, 2048, wtbr + (size_t)(l * 3 + b) * 2048 * 1024, base, tile);
            tr_cvt(P.in[24] + (size_t)l * 2048 * 2048, 2048, 2048, wtout + (size_t)l * 2048 * 2048, base, tile);
            for (int g = 0; g < 4; ++g) tr_cvt(P.in[9] + (size_t)(l * 4 + g) * 65536, 256, 256, wtpool + (size_t)(l * 4 + g) * 65536, base, tile);
            tr_cvt(P.in[13] + (size_t)l * 64 * 1024, 64, 1024, wupt + (size_t)l * 1024 * 64, base, tile);
            tr_cvt(P.in[15] + (size_t)l * 64 * 1024, 64, 1024, aupt + (size_t)l * 1024 * 64, base, tile);
        }
    }
    rms_rows<true>(P.in[0], P.in[1], P.in[7], hbuf, nullptr);
    grid.sync();

    layer_body<0>(P, xb, smem);
    layer_body<1>(P, xb, smem);
    rms_rows<false>(P.out, P.out + (size_t)MP * D, P.in[25], nullptr, P.out);
}

extern "C" void kernel_launch(void* const* d_in, const int* in_sizes, int n_in, void* d_out, int out_size, void* d_ws, size_t ws_size, hipStream_t stream) {
    static int grid_blocks = 0;
    if (grid_blocks == 0) {
        if (n_in != 26 || (size_t)out_size != O_END || ws_size < WS_END) {
            fprintf(stderr, "kernel_launch: unexpected shapes: n_in %d out %d ws %zu (need %zu)\n", n_in, out_size, ws_size, (size_t)WS_END); grid_blocks = -1; return; }
        int dev = 0, cus = 0, per_cu = 0;
        hipGetDevice(&dev);
        hipDeviceGetAttribute(&cus, hipDeviceAttributeMultiprocessorCount, dev);
        hipFuncSetAttribute((const void*)fwd_megakernel, hipFuncAttributeMaxDynamicSharedMemorySize, LDS_BYTES);
        hipOccupancyMaxActiveBlocksPerMultiprocessor(&per_cu, (const void*)fwd_megakernel, 512, LDS_BYTES);
        if (per_cu < 1) per_cu = 1;
        grid_blocks = cus * per_cu;
        if (grid_blocks > 256) grid_blocks = 256;
    }
    if (grid_blocks < 0) return;
    Params p{};
    for (int i = 0; i < 26; ++i) p.in[i] = (const float*)d_in[i];
    p.out = (float*)d_out; p.ws = (unsigned char*)d_ws;
    (void)hipMemsetAsync((char*)d_ws + WS_BAR, 0, 16384, stream);
    void* args[] = {&p};
    hipError_t e = hipLaunchCooperativeKernel((const void*)fwd_megakernel, dim3(grid_blocks), dim3(512), args, LDS_BYTES, stream);
    if (e != hipSuccess) fprintf(stderr, "cooperative launch failed: %s (grid %d)\n", hipGetErrorString(e), grid_blocks);
}
```
